# Optimizing an MI355X kernel written in HIP

```python
import math
import jax
import jax.numpy as jnp
from jax import lax
import numpy as np

D_MODEL = 1024
BATCH = 4
SEQ = 4096
DEPTH = 2

GRID_W = 64
HEAD_DIM = 64
QUERY_BLOCK = 128
ROPE_THETA = 500000.0
ROPE_FRACTION = 4
LN_EPS = 1e-5
NA_HEADS = 4
NA_ROWS = 8
NA_COLS = 16
DIFF_HEADS = 4
DIFF_QK_DIM = 32
DIFF_V_DIM = 2 * DIFF_QK_DIM
POOL_WINDOWS = (2, 4, 8, 16)
POOL_GROUP = 64
POOL_WIDTH = len(POOL_WINDOWS) * POOL_GROUP
DIL_HEADS = 4
DIL_PATTERNS = ((128, 1), (512, 4), (2048, 16))
N_BRANCHES = 4
BRANCH_WIDTH = 256
COLS_NA = 3 * NA_HEADS * HEAD_DIM
COLS_DIFF = 2 * DIFF_HEADS * 2 * DIFF_QK_DIM + DIFF_HEADS * DIFF_V_DIM
COLS_POOL = POOL_WIDTH
COLS_DIL = len(DIL_PATTERNS) * 3 * DIL_HEADS * HEAD_DIM
COLS_GATE = N_BRANCHES * D_MODEL
IN_SPLITS = (COLS_NA, COLS_NA + COLS_DIFF, COLS_NA + COLS_DIFF + COLS_POOL,
             COLS_NA + COLS_DIFF + COLS_POOL + COLS_DIL)
IN_COLS = IN_SPLITS[-1] + COLS_GATE
N_GROUPS = 4
EXPERTS_PER_GROUP = 8
N_EXPERTS = N_GROUPS * EXPERTS_PER_GROUP
TOP_K = 2
D_EXPERT = 512
MOE_BLOCK = 128
ALPHA = (2 * DEPTH) ** 0.25
BETA = (8 * DEPTH) ** -0.25

kernel_name = 'hybrid_gated_encoder_hmoe'


def layer_norm(x, g, b):
    xf = x.astype(jnp.float32)
    mu = jnp.mean(xf, axis=-1, keepdims=True)
    var = jnp.mean(jnp.square(xf - mu), axis=-1, keepdims=True)
    return ((xf - mu) * lax.rsqrt(var + LN_EPS) * g + b).astype(x.dtype)


def partial_rope(x, pos):
    rot = x.shape[-1] // ROPE_FRACTION
    half = rot // 2
    inv_freq = jnp.exp(jnp.arange(half, dtype=jnp.float32) * (-2.0 * math.log(ROPE_THETA) / rot))
    ang = pos.astype(jnp.float32)[:, None] * inv_freq[None, :]
    cos, sin = jnp.cos(ang), jnp.sin(ang)
    x1 = x[..., :half].astype(jnp.float32)
    x2 = x[..., half:rot].astype(jnp.float32)
    return jnp.concatenate([(x1 * cos - x2 * sin).astype(x.dtype),
                            (x1 * sin + x2 * cos).astype(x.dtype), x[..., rot:]], axis=-1)


def neighbourhood_attention(q, k, v, rpb):
    b, h, s, d = q.shape
    rows = s // GRID_W
    kr = min(NA_ROWS, rows)
    kc = NA_COLS
    qg = q.reshape(b, h, rows, GRID_W, d)
    kg = k.reshape(b, h, rows, GRID_W, d)
    vg = v.reshape(b, h, rows, GRID_W, d)
    r = jnp.arange(rows)
    row_idx = jnp.clip(r - kr // 2, 0, rows - kr)[:, None] + jnp.arange(kr)[None, :]
    k_rows = kg[:, :, row_idx]
    v_rows = vg[:, :, row_idx]
    sc = jnp.einsum('bhrqd,bhrkcd->bhrqkc', qg, k_rows).astype(jnp.float32) * d ** -0.5
    col = jnp.arange(GRID_W)
    col_start = jnp.clip(col - kc // 2, 0, GRID_W - kc)
    in_win = (col[None, :] >= col_start[:, None]) & (col[None, :] < col_start[:, None] + kc)
    dr = row_idx - r[:, None] + NA_ROWS - 1
    dc = jnp.clip(col[None, :] - col[:, None] + kc - 1, 0, 2 * kc - 2)
    bias = rpb[:, dr][..., dc].transpose(0, 1, 3, 2, 4).astype(jnp.float32)
    sc = jnp.where(in_win[:, None, :], sc + bias[None], -jnp.inf)
    p = jax.nn.softmax(sc, axis=(-2, -1))
    o = jnp.einsum('bhrqkc,bhrkcd->bhrqd', p.astype(v.dtype), v_rows)
    return o.reshape(b, h, s, d)


def differential_attention(q, k, v, lam, lam_init, subln_g):
    b, h, _, s, dq = q.shape
    nb = s // QUERY_BLOCK
    qb = q.reshape(b, h, 2, nb, QUERY_BLOCK, dq).transpose(3, 0, 1, 2, 4, 5)

    def block(qblk):
        sc = jnp.einsum('bhmqd,bhmkd->bhmqk', qblk, k).astype(jnp.float32) * dq ** -0.5
        p = jax.nn.softmax(sc, axis=-1)
        a = p[:, :, 0] - lam * p[:, :, 1]
        return jnp.einsum('bhqk,bhkd->bhqd', a.astype(v.dtype), v)

    o = lax.map(block, qb)
    o = o.transpose(1, 2, 0, 3, 4).reshape(b, h, s, -1).astype(jnp.float32)
    o = o * lax.rsqrt(jnp.mean(o * o, axis=-1, keepdims=True) + LN_EPS) * subln_g * (1.0 - lam_init)
    return o.astype(v.dtype)


def multiscale_pool(u, pool_w, pool_scale):
    b, s, _ = u.shape
    ng = len(POOL_WINDOWS)
    ug = u.reshape(b, s, ng, POOL_GROUP).astype(jnp.float32)
    cs = jnp.concatenate([jnp.zeros((b, 1, ng, POOL_GROUP), jnp.float32), jnp.cumsum(ug, axis=1)], axis=1)
    t = jnp.arange(s)
    outs = []
    for gi, w in enumerate(POOL_WINDOWS):
        lo = jnp.maximum(t - w // 2, 0)
        hi = jnp.minimum(t + w - 1 - w // 2, s - 1)
        csg = cs[:, :, gi]
        mean = (csg[:, hi + 1] - csg[:, lo]) / (hi - lo + 1).astype(jnp.float32)[:, None]
        outs.append(mean - ug[:, :, gi])
    dlt = jnp.stack(outs, axis=2).astype(u.dtype)
    y = jnp.einsum('bsgc,gce->bsge', dlt, pool_w).reshape(b, s, -1)
    return y * pool_scale


def dilated_pattern(q, k, v, window, dilation):
    b, h, s, d = q.shape
    half = window // (2 * dilation)
    length = s // dilation
    qb = math.gcd(QUERY_BLOCK, length)
    nb = length // qb
    band = qb + 2 * half

    def sub(x):
        return x.reshape(b, h, length, dilation, d).transpose(0, 1, 3, 2, 4)

    pad = ((0, 0), (0, 0), (0, 0), (half, half), (0, 0))
    kp = jnp.pad(sub(k), pad)
    vp = jnp.pad(sub(v), pad)
    idx = jnp.arange(nb)[:, None] * qb + jnp.arange(band)[None, :]
    kb = kp[:, :, :, idx]
    vb = vp[:, :, :, idx]
    qblk = sub(q).reshape(b, h, dilation, nb, qb, d)
    sc = jnp.einsum('bhmnqd,bhmnkd->bhmnqk', qblk, kb).astype(jnp.float32) * d ** -0.5
    a = jnp.arange(qb)[:, None]
    c = jnp.arange(band)[None, :]
    in_win = (c >= a) & (c <= a + 2 * half)
    in_seq = (idx >= half) & (idx < length + half)
    sc = jnp.where(in_win[None] & in_seq[:, None, :], sc, -jnp.inf)
    m = jnp.max(sc, axis=-1, keepdims=True)
    e = jnp.exp(sc - m)
    den = jnp.sum(e, axis=-1, keepdims=True)
    o = jnp.einsum('bhmnqk,bhmnkd->bhmnqd', (e / den).astype(v.dtype), vb)
    lse = (m + jnp.log(den))[..., 0]
    o = o.reshape(b, h, dilation, length, d).transpose(0, 1, 3, 2, 4).reshape(b, h, s, d)
    lse = lse.reshape(b, h, dilation, length).transpose(0, 1, 3, 2).reshape(b, h, s)
    return o, lse


def token_mixing(hs, pos, lam_init, w_in, b_gate, na_rpb, diff_lam, diff_subln_g,
                 pool_w, pool_scale, w_branch, w_out):
    b, s, dm = hs.shape
    z = hs @ w_in
    z_na, z_diff, z_pool, z_dil, z_gate = jnp.split(z, IN_SPLITS, axis=-1)

    def heads(t, n):
        return t.reshape(b, s, n, -1).transpose(0, 2, 1, 3)

    def unheads(t):
        return t.transpose(0, 2, 1, 3).reshape(b, s, -1).astype(hs.dtype)

    qa, ka, va = jnp.split(z_na, 3, axis=-1)
    y_a = unheads(neighbourhood_attention(heads(qa, NA_HEADS), heads(ka, NA_HEADS), heads(va, NA_HEADS), na_rpb))

    qkw = DIFF_HEADS * 2 * DIFF_QK_DIM
    qd = z_diff[..., :qkw].reshape(b, s, DIFF_HEADS, 2, DIFF_QK_DIM).transpose(0, 2, 3, 1, 4)
    kd = z_diff[..., qkw:2 * qkw].reshape(b, s, DIFF_HEADS, 2, DIFF_QK_DIM).transpose(0, 2, 3, 1, 4)
    vd = heads(z_diff[..., 2 * qkw:], DIFF_HEADS)
    dl = diff_lam.astype(jnp.float32)
    lam = jnp.exp(jnp.sum(dl[0] * dl[1])) - jnp.exp(jnp.sum(dl[2] * dl[3])) + lam_init
    y_b = unheads(differential_attention(partial_rope(qd, pos), partial_rope(kd, pos), vd,
                                         lam, lam_init, diff_subln_g))

    y_c = multiscale_pool(z_pool, pool_w, pool_scale).astype(hs.dtype)

    zd = z_dil.reshape(b, s, len(DIL_PATTERNS), 3, DIL_HEADS, HEAD_DIM).transpose(2, 3, 0, 4, 1, 5)
    outs, lses = [], []
    for pi, (w, r) in enumerate(DIL_PATTERNS):
        o, l = dilated_pattern(partial_rope(zd[pi, 0], pos), partial_rope(zd[pi, 1], pos), zd[pi, 2], w, r)
        outs.append(o)
        lses.append(l)
    o_all = jnp.stack(outs)
    w_all = jax.nn.softmax(jnp.stack(lses), axis=0)
    y_d = jnp.einsum('pbhs,pbhsd->bshd', w_all.astype(o_all.dtype), o_all).reshape(b, s, -1).astype(hs.dtype)

    ys = jnp.stack([y_a, y_b, y_c, y_d], axis=2)
    gates = jax.nn.sigmoid((z_gate + b_gate).astype(jnp.float32)).reshape(b, s, N_BRANCHES, dm)
    proj = jnp.einsum('bsnc,ncd->bsnd', ys, w_branch)
    merged = jnp.sum(gates.astype(proj.dtype) * proj, axis=2)
    return merged @ w_out


def routed_experts(t, eid, gate, w_gate, w_up, w_down):
    n_tok, dm = t.shape
    n_slots = n_tok * TOP_K
    n_exp = w_gate.shape[0]
    flat_e = eid.reshape(-1).astype(jnp.int32)
    order = jnp.argsort(flat_e)
    sorted_e = flat_e[order]
    counts = jnp.zeros((n_exp,), jnp.int32).at[flat_e].add(1)
    padded = (counts + MOE_BLOCK - 1) // MOE_BLOCK * MOE_BLOCK
    pad_end = jnp.cumsum(padded)
    pad_start = pad_end - padded
    cnt_start = jnp.cumsum(counts) - counts
    dest = pad_start[sorted_e] + jnp.arange(n_slots, dtype=jnp.int32) - cnt_start[sorted_e]
    n_blocks = (n_slots + n_exp * (MOE_BLOCK - 1) + MOE_BLOCK - 1) // MOE_BLOCK
    cap = n_blocks * MOE_BLOCK
    buf_tok = jnp.full((cap,), n_tok, jnp.int32).at[dest].set((order // TOP_K).astype(jnp.int32))
    t_pad = jnp.concatenate([t, jnp.zeros((1, dm), t.dtype)], axis=0)
    xs = t_pad[buf_tok].reshape(n_blocks, MOE_BLOCK, dm)
    block_e = jnp.minimum(jnp.searchsorted(pad_end, jnp.arange(n_blocks, dtype=jnp.int32) * MOE_BLOCK,
                                           side='right'), n_exp - 1)

    def expert_block(args):
        xb, e = args
        return (jax.nn.silu(xb @ w_gate[e]) * (xb @ w_up[e])) @ w_down[e]

    ys = lax.map(expert_block, (xs, block_e)).reshape(cap, dm)
    slot_dest = jnp.zeros((n_slots,), jnp.int32).at[order].set(dest)
    y = ys[slot_dest].reshape(n_tok, TOP_K, dm)
    return jnp.einsum('tk,tkd->td', gate.astype(y.dtype), y)


def hierarchical_moe(hs, rg_w, rg_b, re_w, re_b, w_gate, w_up, w_down):
    b, s, dm = hs.shape
    t = hs.reshape(-1, dm)
    n_tok = t.shape[0]
    tok = jnp.arange(n_tok)
    glog = (t @ rg_w + rg_b).astype(jnp.float32)
    gsel = jnp.argmax(glog, axis=-1)
    pg = jax.nn.softmax(glog, axis=-1)[tok, gsel]
    elog = (t @ re_w + re_b).astype(jnp.float32).reshape(n_tok, N_GROUPS, EXPERTS_PER_GROUP)
    esel = elog[tok, gsel]
    top_v, top_i = lax.top_k(esel, TOP_K)
    gate = jax.nn.softmax(top_v, axis=-1) * pg[:, None]
    eid = gsel[:, None] * EXPERTS_PER_GROUP + top_i
    return routed_experts(t, eid, gate, w_gate, w_up, w_down).reshape(b, s, dm)


def setup_inputs(seed: int = 0) -> dict:
    key = jax.random.key(seed)
    ks = jax.random.split(key, 23)

    def nrm(k, shape, scale):
        return jax.random.normal(k, shape, jnp.float32) * scale

    L = DEPTH
    return {
        'x': nrm(ks[0], (BATCH, SEQ, D_MODEL), 1.0),
        'emb_ln_g': 1.0 + nrm(ks[1], (D_MODEL,), 0.02),
        'emb_ln_b': nrm(ks[2], (D_MODEL,), 0.02),
        'w_in': nrm(ks[3], (L, D_MODEL, IN_COLS), D_MODEL ** -0.5),
        'b_gate': nrm(ks[4], (L, COLS_GATE), 0.02),
        'na_rpb': nrm(ks[5], (L, NA_HEADS, 2 * NA_ROWS - 1, 2 * NA_COLS - 1), 0.1),
        'diff_lam': nrm(ks[6], (L, 4, DIFF_QK_DIM), 0.1),
        'diff_subln_g': 1.0 + nrm(ks[7], (L, DIFF_V_DIM), 0.02),
        'pool_w': nrm(ks[8], (L, len(POOL_WINDOWS), POOL_GROUP, POOL_GROUP), POOL_GROUP ** -0.5),
        'pool_scale': 1.0 + nrm(ks[9], (L, POOL_WIDTH), 0.02),
        'w_branch': nrm(ks[10], (L, N_BRANCHES, BRANCH_WIDTH, D_MODEL), BETA * BRANCH_WIDTH ** -0.5),
        'w_out': nrm(ks[11], (L, D_MODEL, D_MODEL), BETA * D_MODEL ** -0.5),
        'ln1_g': 1.0 + nrm(ks[12], (L, D_MODEL), 0.02),
        'ln1_b': nrm(ks[13], (L, D_MODEL), 0.02),
        'router_group_w': nrm(ks[14], (L, D_MODEL, N_GROUPS), D_MODEL ** -0.5),
        'router_group_b': nrm(ks[15], (L, N_GROUPS), 0.01),
        'router_expert_w': nrm(ks[16], (L, D_MODEL, N_EXPERTS), D_MODEL ** -0.5),
        'router_expert_b': nrm(ks[17], (L, N_EXPERTS), 0.01),
        'expert_w_gate': nrm(ks[18], (L, N_EXPERTS, D_MODEL, D_EXPERT), D_MODEL ** -0.5),
        'expert_w_up': nrm(ks[19], (L, N_EXPERTS, D_MODEL, D_EXPERT), BETA * D_MODEL ** -0.5),
        'expert_w_down': nrm(ks[20], (L, N_EXPERTS, D_EXPERT, D_MODEL), BETA * D_EXPERT ** -0.5),
        'ln2_g': 1.0 + nrm(ks[21], (L, D_MODEL), 0.02),
        'ln2_b': nrm(ks[22], (L, D_MODEL), 0.02),
    }


def reference(x, emb_ln_g, emb_ln_b, w_in, b_gate, na_rpb, diff_lam, diff_subln_g, pool_w, pool_scale,
              w_branch, w_out, ln1_g, ln1_b, router_group_w, router_group_b, router_expert_w,
              router_expert_b, expert_w_gate, expert_w_up, expert_w_down, ln2_g, ln2_b):
    pos = jnp.arange(x.shape[1], dtype=jnp.int32)
    h = layer_norm(x, emb_ln_g, emb_ln_b)
    for l in range(DEPTH):
        lam_init = 0.8 - 0.6 * math.exp(-0.3 * l)
        mix = token_mixing(h, pos, lam_init, w_in[l], b_gate[l], na_rpb[l], diff_lam[l], diff_subln_g[l],
                           pool_w[l], pool_scale[l], w_branch[l], w_out[l])
        h = layer_norm(ALPHA * h + mix, ln1_g[l], ln1_b[l])
        ffn = hierarchical_moe(h, router_group_w[l], router_group_b[l], router_expert_w[l], router_expert_b[l],
                               expert_w_gate[l], expert_w_up[l], expert_w_down[l])
        h = layer_norm(ALPHA * h + ffn, ln2_g[l], ln2_b[l])
    return h
```

```cpp
#include <hip/hip_runtime.h>
#include <hip/hip_cooperative_groups.h>
#include <cstdio>
#include <cstdint>
#include <cmath>
namespace cg = cooperative_groups;

constexpr int NB = 4, SEQ = 4096, DM = 1024, MT = NB * SEQ, NLAYER = 2;
constexpr int ZC = 4096, GC = 4096, INC = 8192;
constexpr int C_NAQ = 0, C_NAK = 256, C_NAV = 512, C_DFQ = 768, C_DFK = 1024, C_DFV = 1280, C_PL = 1536, C_DL = 1792;
constexpr int NEXP = 32, DEXP = 512, CAP = 40960, NTILE = CAP / 256;
constexpr float LN_EPS = 1e-5f;
constexpr float ALPHA = 1.41421356237309515f;

typedef unsigned short bf16_t;
typedef float f32x4 __attribute__((ext_vector_type(4)));
typedef unsigned u32x4 __attribute__((ext_vector_type(4)));
typedef unsigned u32x2 __attribute__((ext_vector_type(2)));

constexpr size_t MiB = 1u << 20;
constexpr size_t WS_CTL = 0, CTL_BYTES = 1 * MiB;
constexpr size_t WS_ROPE8 = 1 * MiB;
constexpr size_t WS_ROPE16 = WS_ROPE8 + 2 * 4096 * 4 * 4;
constexpr size_t WS_EID = 2 * MiB;
constexpr size_t WS_GW = WS_EID + (size_t)MT * 2 * 4;
constexpr size_t WS_SLOT = WS_GW + (size_t)MT * 2 * 4;
constexpr size_t WS_TOK = WS_SLOT + (size_t)MT * 2 * 4;
constexpr size_t WS_TILEE = WS_TOK + (size_t)CAP * 4;
constexpr size_t WS_HB = 4 * MiB;
constexpr size_t WS_YS = 36 * MiB;
constexpr size_t WS_ZMIX = 68 * MiB;
constexpr size_t WS_GATES = 196 * MiB;
constexpr size_t WS_YPRE = 196 * MiB;
constexpr size_t WS_HMID = 148 * MiB;
constexpr size_t WS_YEXP = 260 * MiB;
constexpr size_t WS_END = 512 * MiB;
constexpr int CW_CNT = 1024;
constexpr int CW_CUR = 1024 + 64;

constexpr int LDS_BYTES = 147456;
constexpr int NTHR = 512;

struct Args {
    const float* in[23];
    float* out;
    unsigned char* ws;
    double invf8[4];
    double invf16[8];
    int ph_lo, ph_hi;
};

__device__ __forceinline__ float bf2f(bf16_t v) { return __uint_as_float(((unsigned)v) << 16); }
__device__ __forceinline__ unsigned f2bf(float f) { unsigned u = __float_as_uint(f); return (u + 0x7fffu + ((u >> 16) & 1u)) >> 16; }
__device__ __forceinline__ unsigned pk2(float lo, float hi) { return f2bf(lo) | (f2bf(hi) << 16); }
__device__ __forceinline__ float lo16(unsigned w) { return __uint_as_float(w << 16); }
__device__ __forceinline__ float hi16(unsigned w) { return __uint_as_float(w & 0xffff0000u); }
__device__ __forceinline__ float wave_sum(float v) {
#pragma unroll
    for (int o = 1; o < 64; o <<= 1) v += __shfl_xor(v, o);
    return v;
}
__device__ __forceinline__ void wave_ln_store(f32x4 (&v)[4], const float* g, const float* bta, float* hrow, bf16_t* hbrow, int lane) {
    float s = 0.f;
#pragma unroll
    for (int j = 0; j < 4; ++j) s += (v[j].x + v[j].y) + (v[j].z + v[j].w);
    const float mean = wave_sum(s) * (1.f / DM);
    float s2 = 0.f;
#pragma unroll
    for (int j = 0; j < 4; ++j) { v[j] = v[j] - mean; s2 += (v[j].x * v[j].x + v[j].y * v[j].y) + (v[j].z * v[j].z + v[j].w * v[j].w); }
    const float rstd = 1.f / sqrtf(wave_sum(s2) * (1.f / DM) + LN_EPS);
#pragma unroll
    for (int j = 0; j < 4; ++j) {
        const int c = 4 * lane + 256 * j;
        const f32x4 gg = *(const f32x4*)(g + c), bb = *(const f32x4*)(bta + c);
        f32x4 o = v[j] * rstd * gg + bb;
        v[j] = o;
        *(f32x4*)(hrow + c) = o;
        u32x2 w; w.x = pk2(o.x, o.y); w.y = pk2(o.z, o.w);
        *(u32x2*)(hbrow + c) = w;
    }
}

template <class AF, class BF, class EF>
__device__ __forceinline__ void ngemm_tile(float* sm, int K, AF af, BF bf, EF ef) {
    float* As = sm;
    float* Bs = sm + 16 * 68;
    const int tid = threadIdx.x, tx = tid & 31, ty = tid >> 5;
    f32x4 acc[4];
#pragma unroll
    for (int i = 0; i < 4; ++i) acc[i] = (f32x4){0.f, 0.f, 0.f, 0.f};
    const int arow = tid >> 3, ak = (tid & 7) * 2, bk = tid >> 5, bc = (tid & 31) * 4;
    for (int k0 = 0; k0 < K; k0 += 16) {
        const float a0 = af(arow, k0 + ak), a1 = af(arow, k0 + ak + 1);
        const f32x4 b = bf(k0 + bk, bc);
        __syncthreads();
        As[ak * 68 + arow] = a0; As[(ak + 1) * 68 + arow] = a1;
        *(f32x4*)(Bs + bk * 128 + bc) = b;
        __syncthreads();
#pragma unroll
        for (int kk = 0; kk < 16; ++kk) {
            const f32x4 a = *(const f32x4*)(As + kk * 68 + ty * 4);
            const f32x4 bb = *(const f32x4*)(Bs + kk * 128 + tx * 4);
            acc[0] += a.x * bb; acc[1] += a.y * bb; acc[2] += a.z * bb; acc[3] += a.w * bb;
        }
    }
#pragma unroll
    for (int i = 0; i < 4; ++i) ef(ty * 4 + i, tx * 4, acc[i]);
}

struct Ctx {
    const Args* a; int tid, lane, wave, bid, nblk; int gw, ngw; long gtid, ngt;
    float* sm; unsigned char* ws; float* h;
};
#define c_hb     ((bf16_t*)(c.ws + WS_HB))
#define c_merged ((bf16_t*)(c.ws + WS_HB))
#define c_ys     ((bf16_t*)(c.ws + WS_YS))
#define c_zmix   ((bf16_t*)(c.ws + WS_ZMIX))
#define c_gates  ((bf16_t*)(c.ws + WS_GATES))
#define c_ypre   ((float*)(c.ws + WS_YPRE))
#define c_hmid   ((bf16_t*)(c.ws + WS_HMID))
#define c_yexp   ((bf16_t*)(c.ws + WS_YEXP))
#define c_eid    ((int*)(c.ws + WS_EID))
#define c_gwt    ((float*)(c.ws + WS_GW))
#define c_slot   ((int*)(c.ws + WS_SLOT))
#define c_tok    ((int*)(c.ws + WS_TOK))
#define c_tile_e ((int*)(c.ws + WS_TILEE))
#define c_ctl    ((unsigned*)(c.ws + WS_CTL))
#define c_rc8    ((float*)(c.ws + WS_ROPE8))
#define c_rs8    ((float*)(c.ws + WS_ROPE8) + 4096 * 4)
#define c_rc16   ((float*)(c.ws + WS_ROPE16))
#define c_rs16   ((float*)(c.ws + WS_ROPE16) + 4096 * 8)

__device__ __forceinline__ void st_prologue(Ctx& c) {
    const Args& A = *c.a;
    for (long i = c.gtid; i < 4096; i += c.ngt) {
        const int pos = (int)i;
#pragma unroll
        for (int j = 0; j < 12; ++j) {
            const double f = j < 4 ? A.invf8[j < 4 ? j : 0] : A.invf16[j < 4 ? 0 : j - 4];
            const double ang = (double)pos * f;
            const double kk = __builtin_rint(ang * 0.15915494309189535);
            const float r = (float)(ang - kk * 6.283185307179586);
            const float cs = cosf(r), sn = sinf(r);
            if (j < 4) { c_rc8[pos * 4 + j] = cs; c_rs8[pos * 4 + j] = sn; }
            else { c_rc16[pos * 8 + j - 4] = cs; c_rs16[pos * 8 + j - 4] = sn; }
        }
    }
    const float* x = A.in[0];
    for (int m = c.gw; m < MT; m += c.ngw) {
        f32x4 v[4];
#pragma unroll
        for (int j = 0; j < 4; ++j) v[j] = *(const f32x4*)(x + (size_t)m * DM + 4 * c.lane + 256 * j);
        wave_ln_store(v, A.in[1], A.in[2], c.h + (size_t)m * DM, c_hb + (size_t)m * DM, c.lane);
    }
}

__device__ __forceinline__ void st_zgemm(Ctx& c, int l) {
    const float* W = c.a->in[3] + (size_t)l * DM * INC;
    const float* bg = c.a->in[4] + (size_t)l * GC;
    for (int t = c.bid; t < (MT / 64) * (INC / 128); t += c.nblk) {
        const int tn = t % (INC / 128), tm = t / (INC / 128), m0 = tm * 64, n0 = tn * 128;
        const bf16_t* hb = c_hb; bf16_t* zmix = c_zmix; bf16_t* gates = c_gates;
        ngemm_tile(c.sm, DM,
            [&](int r, int k) { return bf2f(hb[(size_t)(m0 + r) * DM + k]); },
            [&](int k, int c4) { return *(const f32x4*)(W + (size_t)k * INC + n0 + c4); },
            [&](int r, int c4, f32x4 v) {
                const int col = n0 + c4; const size_t row = (size_t)(m0 + r);
                if (col < ZC) { u32x2 w; w.x = pk2(v.x, v.y); w.y = pk2(v.z, v.w); *(u32x2*)(zmix + row * ZC + col) = w; }
                else { const f32x4 b = *(const f32x4*)(bg + col - ZC); f32x4 s;
                    s.x = 1.f / (1.f + __expf(-(v.x + b.x))); s.y = 1.f / (1.f + __expf(-(v.y + b.y)));
                    s.z = 1.f / (1.f + __expf(-(v.z + b.z))); s.w = 1.f / (1.f + __expf(-(v.w + b.w)));
                    u32x2 w; w.x = pk2(s.x, s.y); w.y = pk2(s.z, s.w); *(u32x2*)(gates + row * GC + col - ZC) = w; }
            });
    }
}

__device__ __forceinline__ void st_rope(Ctx& c) {
    for (long i = c.gtid; i < (long)MT * 256; i += c.ngt) {
        const int t = (int)(i >> 8), j = (int)(i & 255), pos = t & (SEQ - 1);
        int col1, col2; float cs, sn;
        if (j < 64) { const int qk = j >> 5, hh = (j >> 3) & 3, m = (j >> 2) & 1, ii = j & 3;
            col1 = C_DFQ + qk * 256 + hh * 64 + m * 32 + ii; col2 = col1 + 4; cs = c_rc8[pos * 4 + ii]; sn = c_rs8[pos * 4 + ii]; }
        else { const int jj = j - 64, p = jj >> 6, r = jj & 63, qk = r >> 5, hh = (r >> 3) & 3, ii = r & 7;
            col1 = C_DL + p * 768 + qk * 256 + hh * 64 + ii; col2 = col1 + 8; cs = c_rc16[pos * 8 + ii]; sn = c_rs16[pos * 8 + ii]; }
        bf16_t* zr = c_zmix + (size_t)t * ZC;
        const float x1 = bf2f(zr[col1]), x2 = bf2f(zr[col2]);
        zr[col1] = (bf16_t)f2bf(x1 * cs - x2 * sn); zr[col2] = (bf16_t)f2bf(x1 * sn + x2 * cs);
    }
}

#define LOAD8(dst, p) const u32x4 dst = *(const u32x4*)(p)

__device__ __forceinline__ void st_na(Ctx& c, int l) {
    const float* rpb = c.a->in[5] + (size_t)l * 4 * 15 * 31;
    for (long i = c.gtid; i < (long)MT * 4; i += c.ngt) {
        const int s = (int)(i & (SEQ - 1)), hh = (int)((i >> 12) & 3), b = (int)(i >> 14);
        const int r = s >> 6, cq = s & 63;
        const int rs = min(max(r - 4, 0), 56), cs = min(max(cq - 8, 0), 48);
        const size_t t = (size_t)b * SEQ + s;
        float q[64], o[64];
        {
            const bf16_t* qp = c_zmix + t * ZC + C_NAQ + hh * 64;
#pragma unroll
            for (int d8 = 0; d8 < 8; ++d8) { LOAD8(w, qp + d8 * 8);
                q[d8 * 8 + 0] = lo16(w.x) * 0.125f; q[d8 * 8 + 1] = hi16(w.x) * 0.125f; q[d8 * 8 + 2] = lo16(w.y) * 0.125f; q[d8 * 8 + 3] = hi16(w.y) * 0.125f;
                q[d8 * 8 + 4] = lo16(w.z) * 0.125f; q[d8 * 8 + 5] = hi16(w.z) * 0.125f; q[d8 * 8 + 6] = lo16(w.w) * 0.125f; q[d8 * 8 + 7] = hi16(w.w) * 0.125f; }
        }
#pragma unroll
        for (int d = 0; d < 64; ++d) o[d] = 0.f;
        float mx = -INFINITY, ls = 0.f;
        for (int kk = 0; kk < 8; ++kk) {
            const int kr = rs + kk, dr = kr - r + 7;
            for (int cc = 0; cc < 16; ++cc) {
                const int ck = cs + cc, dc = ck - cq + 15;
                const size_t tk = (size_t)b * SEQ + kr * 64 + ck;
                const bf16_t* kp = c_zmix + tk * ZC + C_NAK + hh * 64;
                const bf16_t* vp = c_zmix + tk * ZC + C_NAV + hh * 64;
                float sc = rpb[(hh * 15 + dr) * 31 + dc];
#pragma unroll
                for (int d8 = 0; d8 < 8; ++d8) { LOAD8(w, kp + d8 * 8);
                    sc += q[d8 * 8 + 0] * lo16(w.x) + q[d8 * 8 + 1] * hi16(w.x) + q[d8 * 8 + 2] * lo16(w.y) + q[d8 * 8 + 3] * hi16(w.y)
                        + q[d8 * 8 + 4] * lo16(w.z) + q[d8 * 8 + 5] * hi16(w.z) + q[d8 * 8 + 6] * lo16(w.w) + q[d8 * 8 + 7] * hi16(w.w); }
                const float mn = fmaxf(mx, sc), al = __expf(mx - mn), p = __expf(sc - mn);
                ls = ls * al + p; mx = mn;
#pragma unroll
                for (int d8 = 0; d8 < 8; ++d8) { LOAD8(w, vp + d8 * 8);
                    o[d8 * 8 + 0] = o[d8 * 8 + 0] * al + p * lo16(w.x); o[d8 * 8 + 1] = o[d8 * 8 + 1] * al + p * hi16(w.x);
                    o[d8 * 8 + 2] = o[d8 * 8 + 2] * al + p * lo16(w.y); o[d8 * 8 + 3] = o[d8 * 8 + 3] * al + p * hi16(w.y);
                    o[d8 * 8 + 4] = o[d8 * 8 + 4] * al + p * lo16(w.z); o[d8 * 8 + 5] = o[d8 * 8 + 5] * al + p * hi16(w.z);
                    o[d8 * 8 + 6] = o[d8 * 8 + 6] * al + p * lo16(w.w); o[d8 * 8 + 7] = o[d8 * 8 + 7] * al + p * hi16(w.w); }
            }
        }
        const float inv = 1.f / ls;
        bf16_t* yp = c_ys + t * DM + 0 + hh * 64;
#pragma unroll
        for (int d8 = 0; d8 < 8; ++d8) { u32x4 w; w.x = pk2(o[d8 * 8 + 0] * inv, o[d8 * 8 + 1] * inv); w.y = pk2(o[d8 * 8 + 2] * inv, o[d8 * 8 + 3] * inv);
            w.z = pk2(o[d8 * 8 + 4] * inv, o[d8 * 8 + 5] * inv); w.w = pk2(o[d8 * 8 + 6] * inv, o[d8 * 8 + 7] * inv); *(u32x4*)(yp + d8 * 8) = w; }
    }
}

__device__ __forceinline__ void st_diff(Ctx& c, int l) {
    const float* dl = c.a->in[6] + (size_t)l * 4 * 32;
    const float* sg = c.a->in[7] + (size_t)l * 64;
    const float lam_init = 0.8f - 0.6f * expf(-0.3f * (float)l);
    float s01 = 0.f, s23 = 0.f;
    for (int i = 0; i < 32; ++i) { s01 += dl[i] * dl[32 + i]; s23 += dl[64 + i] * dl[96 + i]; }
    const float lam = expf(s01) - expf(s23) + lam_init;
    for (long i = c.gtid; i < (long)MT * 8; i += c.ngt) {
        const int m = (int)(i & 1), s = (int)((i >> 1) & (SEQ - 1)), hh = (int)((i >> 13) & 3), b = (int)(i >> 15);
        const size_t t = (size_t)b * SEQ + s;
        float q[32], o[64];
        { const bf16_t* qp = c_zmix + t * ZC + C_DFQ + hh * 64 + m * 32;
#pragma unroll
          for (int d8 = 0; d8 < 4; ++d8) { LOAD8(w, qp + d8 * 8); const float sc = 0.17677669529663687f;
              q[d8 * 8 + 0] = lo16(w.x) * sc; q[d8 * 8 + 1] = hi16(w.x) * sc; q[d8 * 8 + 2] = lo16(w.y) * sc; q[d8 * 8 + 3] = hi16(w.y) * sc;
              q[d8 * 8 + 4] = lo16(w.z) * sc; q[d8 * 8 + 5] = hi16(w.z) * sc; q[d8 * 8 + 6] = lo16(w.w) * sc; q[d8 * 8 + 7] = hi16(w.w) * sc; } }
#pragma unroll
        for (int d = 0; d < 64; ++d) o[d] = 0.f;
        float mx = -INFINITY, ls = 0.f;
        const bf16_t* kbase = c_zmix + (size_t)b * SEQ * ZC + C_DFK + hh * 64 + m * 32;
        const bf16_t* vbase = c_zmix + (size_t)b * SEQ * ZC + C_DFV + hh * 64;
        for (int j = 0; j < SEQ; ++j) {
            const bf16_t* kp = kbase + (size_t)j * ZC; const bf16_t* vp = vbase + (size_t)j * ZC;
            float sc = 0.f;
#pragma unroll
            for (int d8 = 0; d8 < 4; ++d8) { LOAD8(w, kp + d8 * 8);
                sc += q[d8 * 8 + 0] * lo16(w.x) + q[d8 * 8 + 1] * hi16(w.x) + q[d8 * 8 + 2] * lo16(w.y) + q[d8 * 8 + 3] * hi16(w.y)
                    + q[d8 * 8 + 4] * lo16(w.z) + q[d8 * 8 + 5] * hi16(w.z) + q[d8 * 8 + 6] * lo16(w.w) + q[d8 * 8 + 7] * hi16(w.w); }
            const float mn = fmaxf(mx, sc), al = __expf(mx - mn), p = __expf(sc - mn);
            ls = ls * al + p; mx = mn;
#pragma unroll
            for (int d8 = 0; d8 < 8; ++d8) { LOAD8(w, vp + d8 * 8);
                o[d8 * 8 + 0] = o[d8 * 8 + 0] * al + p * lo16(w.x); o[d8 * 8 + 1] = o[d8 * 8 + 1] * al + p * hi16(w.x);
                o[d8 * 8 + 2] = o[d8 * 8 + 2] * al + p * lo16(w.y); o[d8 * 8 + 3] = o[d8 * 8 + 3] * al + p * hi16(w.y);
                o[d8 * 8 + 4] = o[d8 * 8 + 4] * al + p * lo16(w.z); o[d8 * 8 + 5] = o[d8 * 8 + 5] * al + p * hi16(w.z);
                o[d8 * 8 + 6] = o[d8 * 8 + 6] * al + p * lo16(w.w); o[d8 * 8 + 7] = o[d8 * 8 + 7] * al + p * hi16(w.w); }
        }
        const float inv = 1.f / ls;
        float ss = 0.f;
#pragma unroll
        for (int d = 0; d < 64; ++d) { const float mine = o[d] * inv; const float oth = __shfl_xor(mine, 1); const float a = mine - lam * oth; o[d] = a; ss += a * a; }
        if (m == 0) {
            const float rr = 1.f / sqrtf(ss * (1.f / 64.f) + LN_EPS) * (1.f - lam_init);
            bf16_t* yp = c_ys + t * DM + 256 + hh * 64;
#pragma unroll
            for (int d8 = 0; d8 < 8; ++d8) { u32x4 w;
                w.x = pk2(o[d8 * 8 + 0] * rr * sg[d8 * 8 + 0], o[d8 * 8 + 1] * rr * sg[d8 * 8 + 1]); w.y = pk2(o[d8 * 8 + 2] * rr * sg[d8 * 8 + 2], o[d8 * 8 + 3] * rr * sg[d8 * 8 + 3]);
                w.z = pk2(o[d8 * 8 + 4] * rr * sg[d8 * 8 + 4], o[d8 * 8 + 5] * rr * sg[d8 * 8 + 5]); w.w = pk2(o[d8 * 8 + 6] * rr * sg[d8 * 8 + 6], o[d8 * 8 + 7] * rr * sg[d8 * 8 + 7]);
                *(u32x4*)(yp + d8 * 8) = w; }
        }
    }
}

__device__ __forceinline__ void st_pool(Ctx& c, int l) {
    const float* pw = c.a->in[8] + (size_t)l * 4 * 64 * 64;
    const float* ps = c.a->in[9] + (size_t)l * 256;
    for (long i = c.gtid; i < (long)MT * 256; i += c.ngt) {
        const int t = (int)(i >> 8), cc = (int)(i & 255), g = cc >> 6, e = cc & 63, w = 2 << g;
        const int s = t & (SEQ - 1), b0 = t - s;
        const int lo = max(s - w / 2, 0), hi = min(s + w - 1 - w / 2, SEQ - 1);
        const float inv = 1.f / (float)(hi - lo + 1);
        float acc = 0.f;
        for (int k = 0; k < 64; ++k) {
            float sum = 0.f;
            for (int p = lo; p <= hi; ++p) sum += bf2f(c_zmix[(size_t)(b0 + p) * ZC + C_PL + g * 64 + k]);
            const float dlt = sum * inv - bf2f(c_zmix[(size_t)t * ZC + C_PL + g * 64 + k]);
            acc += dlt * pw[(g * 64 + k) * 64 + e];
        }
        c_ys[(size_t)t * DM + 512 + cc] = (bf16_t)f2bf(acc * ps[cc]);
    }
}

__device__ __forceinline__ void st_dil(Ctx& c) {
    for (long i = c.gtid; i < (long)MT * 4; i += c.ngt) {
        const int s = (int)(i & (SEQ - 1)), hh = (int)((i >> 12) & 3), b = (int)(i >> 14);
        const size_t t = (size_t)b * SEQ + s;
        float q[64], o[64];
#pragma unroll
        for (int d = 0; d < 64; ++d) o[d] = 0.f;
        float mx = -INFINITY, ls = 0.f;
        for (int p = 0; p < 3; ++p) {
            const int sh = 2 * p, r = 1 << sh, L = SEQ >> sh, li = s >> sh, res = s & (r - 1);
            { const bf16_t* qp = c_zmix + t * ZC + C_DL + p * 768 + hh * 64;
#pragma unroll
              for (int d8 = 0; d8 < 8; ++d8) { LOAD8(w, qp + d8 * 8);
                  q[d8 * 8 + 0] = lo16(w.x) * 0.125f; q[d8 * 8 + 1] = hi16(w.x) * 0.125f; q[d8 * 8 + 2] = lo16(w.y) * 0.125f; q[d8 * 8 + 3] = hi16(w.y) * 0.125f;
                  q[d8 * 8 + 4] = lo16(w.z) * 0.125f; q[d8 * 8 + 5] = hi16(w.z) * 0.125f; q[d8 * 8 + 6] = lo16(w.w) * 0.125f; q[d8 * 8 + 7] = hi16(w.w) * 0.125f; } }
            for (int j = -64; j <= 64; ++j) {
                const int lj = li + j;
                if (lj < 0 || lj >= L) continue;
                const size_t tk = (size_t)b * SEQ + ((size_t)lj << sh) + res;
                const bf16_t* kp = c_zmix + tk * ZC + C_DL + p * 768 + 256 + hh * 64;
                const bf16_t* vp = c_zmix + tk * ZC + C_DL + p * 768 + 512 + hh * 64;
                float sc = 0.f;
#pragma unroll
                for (int d8 = 0; d8 < 8; ++d8) { LOAD8(w, kp + d8 * 8);
                    sc += q[d8 * 8 + 0] * lo16(w.x) + q[d8 * 8 + 1] * hi16(w.x) + q[d8 * 8 + 2] * lo16(w.y) + q[d8 * 8 + 3] * hi16(w.y)
                        + q[d8 * 8 + 4] * lo16(w.z) + q[d8 * 8 + 5] * hi16(w.z) + q[d8 * 8 + 6] * lo16(w.w) + q[d8 * 8 + 7] * hi16(w.w); }
                const float mn = fmaxf(mx, sc), al = __expf(mx - mn), pp = __expf(sc - mn);
                ls = ls * al + pp; mx = mn;
#pragma unroll
                for (int d8 = 0; d8 < 8; ++d8) { LOAD8(w, vp + d8 * 8);
                    o[d8 * 8 + 0] = o[d8 * 8 + 0] * al + pp * lo16(w.x); o[d8 * 8 + 1] = o[d8 * 8 + 1] * al + pp * hi16(w.x);
                    o[d8 * 8 + 2] = o[d8 * 8 + 2] * al + pp * lo16(w.y); o[d8 * 8 + 3] = o[d8 * 8 + 3] * al + pp * hi16(w.y);
                    o[d8 * 8 + 4] = o[d8 * 8 + 4] * al + pp * lo16(w.z); o[d8 * 8 + 5] = o[d8 * 8 + 5] * al + pp * hi16(w.z);
                    o[d8 * 8 + 6] = o[d8 * 8 + 6] * al + pp * lo16(w.w); o[d8 * 8 + 7] = o[d8 * 8 + 7] * al + pp * hi16(w.w); }
            }
        }
        const float inv = 1.f / ls;
        bf16_t* yp = c_ys + t * DM + 768 + hh * 64;
#pragma unroll
        for (int d8 = 0; d8 < 8; ++d8) { u32x4 w; w.x = pk2(o[d8 * 8 + 0] * inv, o[d8 * 8 + 1] * inv); w.y = pk2(o[d8 * 8 + 2] * inv, o[d8 * 8 + 3] * inv);
            w.z = pk2(o[d8 * 8 + 4] * inv, o[d8 * 8 + 5] * inv); w.w = pk2(o[d8 * 8 + 6] * inv, o[d8 * 8 + 7] * inv); *(u32x4*)(yp + d8 * 8) = w; }
    }
}

__device__ __forceinline__ void st_merge(Ctx& c, int l) {
    const float* wb = c.a->in[10] + (size_t)l * 4 * 256 * DM;
    for (long i = c.gtid; i < (long)MT * DM; i += c.ngt) {
        const int t = (int)(i >> 10), d = (int)(i & 1023);
        float tot = 0.f;
        for (int n = 0; n < 4; ++n) {
            const bf16_t* yp = c_ys + (size_t)t * DM + n * 256;
            const float* wp = wb + (size_t)n * 256 * DM + d;
            float a = 0.f;
            for (int c8 = 0; c8 < 32; ++c8) { LOAD8(w, yp + c8 * 8); const float* w8 = wp + (size_t)c8 * 8 * DM;
                a += lo16(w.x) * w8[0] + hi16(w.x) * w8[DM] + lo16(w.y) * w8[2 * DM] + hi16(w.y) * w8[3 * DM]
                   + lo16(w.z) * w8[4 * DM] + hi16(w.z) * w8[5 * DM] + lo16(w.w) * w8[6 * DM] + hi16(w.w) * w8[7 * DM]; }
            tot += bf2f(c_gates[(size_t)t * GC + n * DM + d]) * a;
        }
        c_merged[(size_t)t * DM + d] = (bf16_t)f2bf(tot);
    }
}

__device__ __forceinline__ void st_outgemm(Ctx& c, int l) {
    const float* W = c.a->in[11] + (size_t)l * DM * DM;
    for (long i = c.gtid; i < CAP; i += c.ngt) c_tok[i] = -1;
    for (int t = c.bid; t < (MT / 64) * (DM / 128); t += c.nblk) {
        const int tn = t % (DM / 128), tm = t / (DM / 128), m0 = tm * 64, n0 = tn * 128;
        const bf16_t* mg = c_merged; const float* h = c.h; float* ypre = c_ypre;
        ngemm_tile(c.sm, DM,
            [&](int r, int k) { return bf2f(mg[(size_t)(m0 + r) * DM + k]); },
            [&](int k, int c4) { return *(const f32x4*)(W + (size_t)k * DM + n0 + c4); },
            [&](int r, int c4, f32x4 v) { const size_t off = (size_t)(m0 + r) * DM + n0 + c4;
                const f32x4 hv = *(const f32x4*)(h + off); *(f32x4*)(ypre + off) = ALPHA * hv + v; });
    }
}

__device__ __forceinline__ void st_ln1_router(Ctx& c, int l) {
    const float* g1 = c.a->in[12] + (size_t)l * DM; const float* b1 = c.a->in[13] + (size_t)l * DM;
    const float* rgw = c.a->in[14] + (size_t)l * DM * 4; const float* rgb = c.a->in[15] + (size_t)l * 4;
    const float* rew = c.a->in[16] + (size_t)l * DM * 32; const float* reb = c.a->in[17] + (size_t)l * 32;
    unsigned* cnt = c_ctl + CW_CNT + l * 32;
    for (int m = c.gw; m < MT; m += c.ngw) {
        f32x4 v[4];
#pragma unroll
        for (int j = 0; j < 4; ++j) v[j] = *(const f32x4*)(c_ypre + (size_t)m * DM + 4 * c.lane + 256 * j);
        wave_ln_store(v, g1, b1, c.h + (size_t)m * DM, c_hb + (size_t)m * DM, c.lane);
        float gl[4] = {0.f, 0.f, 0.f, 0.f};
#pragma unroll
        for (int j = 0; j < 4; ++j) {
            const int k0 = 4 * c.lane + 256 * j;
#pragma unroll
            for (int e = 0; e < 4; ++e) { const float hv = v[j][e]; const f32x4 w = *(const f32x4*)(rgw + (size_t)(k0 + e) * 4);
                gl[0] += hv * w.x; gl[1] += hv * w.y; gl[2] += hv * w.z; gl[3] += hv * w.w; }
        }
#pragma unroll
        for (int q = 0; q < 4; ++q) gl[q] = wave_sum(gl[q]) + rgb[q];
        int gs = 0; float gm = gl[0];
#pragma unroll
        for (int q = 1; q < 4; ++q) if (gl[q] > gm) { gm = gl[q]; gs = q; }
        float den = 0.f;
#pragma unroll
        for (int q = 0; q < 4; ++q) den += expf(gl[q] - gm);
        const float pg = 1.f / den;
        float el[8];
#pragma unroll
        for (int q = 0; q < 8; ++q) el[q] = 0.f;
#pragma unroll
        for (int j = 0; j < 4; ++j) {
            const int k0 = 4 * c.lane + 256 * j;
#pragma unroll
            for (int e = 0; e < 4; ++e) { const float hv = v[j][e]; const float* wp = rew + (size_t)(k0 + e) * 32 + gs * 8;
                const f32x4 w0 = *(const f32x4*)wp, w1 = *(const f32x4*)(wp + 4);
                el[0] += hv * w0.x; el[1] += hv * w0.y; el[2] += hv * w0.z; el[3] += hv * w0.w;
                el[4] += hv * w1.x; el[5] += hv * w1.y; el[6] += hv * w1.z; el[7] += hv * w1.w; }
        }
#pragma unroll
        for (int q = 0; q < 8; ++q) el[q] = wave_sum(el[q]) + reb[gs * 8 + q];
        int i1 = 0; float v1 = el[0];
#pragma unroll
        for (int q = 1; q < 8; ++q) if (el[q] > v1) { v1 = el[q]; i1 = q; }
        int i2 = -1; float v2 = -INFINITY;
#pragma unroll
        for (int q = 0; q < 8; ++q) if (q != i1 && el[q] > v2) { v2 = el[q]; i2 = q; }
        const float e2 = expf(v2 - v1), g1w = pg / (1.f + e2), g2w = pg * e2 / (1.f + e2);
        if (c.lane == 0) {
            const int ea = gs * 8 + i1, eb = gs * 8 + i2;
            c_eid[m * 2] = ea; c_eid[m * 2 + 1] = eb; c_gwt[m * 2] = g1w; c_gwt[m * 2 + 1] = g2w;
            atomicAdd(cnt + ea, 1u); atomicAdd(cnt + eb, 1u);
        }
    }
}

__device__ __forceinline__ void st_pack(Ctx& c, int l) {
    unsigned* cnt = c_ctl + CW_CNT + l * 32; unsigned* cur = c_ctl + CW_CUR + l * 32;
    int* offs = (int*)c.sm;
    if (c.tid == 0) { int o = 0; for (int e = 0; e < NEXP; ++e) { offs[e] = o; const int n = (int)__hip_atomic_load(cnt + e, __ATOMIC_RELAXED, __HIP_MEMORY_SCOPE_AGENT); o += (n + 255) / 256 * 256; } offs[32] = o; }
    __syncthreads();
    if (c.bid == 0) {
        for (int i = c.tid; i < NTILE; i += NTHR) { const int row = i * 256; int e = -1;
            if (row < offs[32]) { e = 0; for (int q = 1; q < NEXP; ++q) if (row >= offs[q]) e = q; }
            c_tile_e[i] = e; }
    }
    for (long i = c.gtid; i < (long)MT * 2; i += c.ngt) {
        const int e = c_eid[i];
        const int pos = offs[e] + (int)atomicAdd(cur + e, 1u);
        c_slot[i] = pos; c_tok[pos] = (int)(i >> 1);
    }
    __syncthreads();
}

__device__ __forceinline__ float silu(float x) { return x / (1.f + __expf(-x)); }

__device__ __forceinline__ void st_moe1(Ctx& c, int l) {
    const float* WG = c.a->in[18] + (size_t)l * NEXP * DM * DEXP;
    const float* WU = c.a->in[19] + (size_t)l * NEXP * DM * DEXP;
    for (int t = c.bid; t < (CAP / 64) * (DEXP / 64); t += c.nblk) {
        const int tn = t % (DEXP / 64), tm = t / (DEXP / 64), m0 = tm * 64, j0 = tn * 64;
        const int e = c_tile_e[m0 >> 8];
        if (e < 0) continue;
        const float* wg = WG + (size_t)e * DM * DEXP; const float* wu = WU + (size_t)e * DM * DEXP;
        const bf16_t* hb = c_hb; const int* tok = c_tok; bf16_t* hmid = c_hmid;
        ngemm_tile(c.sm, DM,
            [&](int r, int k) { const int tk = tok[m0 + r]; return tk < 0 ? 0.f : bf2f(hb[(size_t)tk * DM + k]); },
            [&](int k, int c4) { return c4 < 64 ? *(const f32x4*)(wg + (size_t)k * DEXP + j0 + c4) : *(const f32x4*)(wu + (size_t)k * DEXP + j0 + c4 - 64); },
            [&](int r, int c4, f32x4 v) {
                f32x4 o; o.x = __shfl_xor(v.x, 16); o.y = __shfl_xor(v.y, 16); o.z = __shfl_xor(v.z, 16); o.w = __shfl_xor(v.w, 16);
                if (c4 < 64) { u32x2 w; w.x = pk2(silu(v.x) * o.x, silu(v.y) * o.y); w.y = pk2(silu(v.z) * o.z, silu(v.w) * o.w);
                    *(u32x2*)(hmid + (size_t)(m0 + r) * DEXP + j0 + c4) = w; }
            });
    }
}

__device__ __forceinline__ void st_moe2(Ctx& c, int l) {
    const float* WD = c.a->in[20] + (size_t)l * NEXP * DEXP * DM;
    for (int t = c.bid; t < (CAP / 64) * (DM / 128); t += c.nblk) {
        const int tn = t % (DM / 128), tm = t / (DM / 128), m0 = tm * 64, n0 = tn * 128;
        const int e = c_tile_e[m0 >> 8];
        if (e < 0) continue;
        const float* wd = WD + (size_t)e * DEXP * DM;
        const bf16_t* hmid = c_hmid; bf16_t* yexp = c_yexp;
        ngemm_tile(c.sm, DEXP,
            [&](int r, int k) { return bf2f(hmid[(size_t)(m0 + r) * DEXP + k]); },
            [&](int k, int c4) { return *(const f32x4*)(wd + (size_t)k * DM + n0 + c4); },
            [&](int r, int c4, f32x4 v) { u32x2 w; w.x = pk2(v.x, v.y); w.y = pk2(v.z, v.w); *(u32x2*)(yexp + (size_t)(m0 + r) * DM + n0 + c4) = w; });
    }
}

__device__ __forceinline__ void st_combine(Ctx& c, int l) {
    const float* g2 = c.a->in[21] + (size_t)l * DM; const float* b2 = c.a->in[22] + (size_t)l * DM;
    for (int m = c.gw; m < MT; m += c.ngw) {
        const int s0 = c_slot[m * 2], s1 = c_slot[m * 2 + 1]; const float w0 = c_gwt[m * 2], w1 = c_gwt[m * 2 + 1];
        f32x4 v[4];
#pragma unroll
        for (int j = 0; j < 4; ++j) {
            const int col = 4 * c.lane + 256 * j;
            const f32x4 hv = *(const f32x4*)(c.h + (size_t)m * DM + col);
            const u32x2 a = *(const u32x2*)(c_yexp + (size_t)s0 * DM + col), b = *(const u32x2*)(c_yexp + (size_t)s1 * DM + col);
            f32x4 r;
            r.x = ALPHA * hv.x + w0 * lo16(a.x) + w1 * lo16(b.x); r.y = ALPHA * hv.y + w0 * hi16(a.x) + w1 * hi16(b.x);
            r.z = ALPHA * hv.z + w0 * lo16(a.y) + w1 * lo16(b.y); r.w = ALPHA * hv.w + w0 * hi16(a.y) + w1 * hi16(b.y);
            v[j] = r;
        }
        wave_ln_store(v, g2, b2, c.h + (size_t)m * DM, c_hb + (size_t)m * DM, c.lane);
    }
}

constexpr int PH_PER_LAYER = 10, N_PHASES = 1 + NLAYER * PH_PER_LAYER;

__global__ void __launch_bounds__(NTHR, 2) fwd(Args args) {
    extern __shared__ __attribute__((aligned(16))) unsigned char lds[];
    cg::grid_group grid = cg::this_grid();
    for (int ph = args.ph_lo; ph < args.ph_hi; ++ph) {
        Ctx c;
        int tid_ = threadIdx.x, bid_ = blockIdx.x, nblk_ = gridDim.x;
        unsigned char* ws_ = args.ws; float* out_ = args.out;
        asm volatile("" : "+v"(tid_), "+s"(bid_), "+s"(nblk_), "+s"(ws_), "+s"(out_));
        c.a = &args; c.tid = tid_; c.lane = c.tid & 63; c.wave = c.tid >> 6; c.bid = bid_; c.nblk = nblk_;
        c.gw = c.bid * (NTHR / 64) + c.wave; c.ngw = c.nblk * (NTHR / 64);
        c.gtid = (long)c.bid * NTHR + c.tid; c.ngt = (long)c.nblk * NTHR;
        c.sm = (float*)lds; c.ws = ws_; c.h = out_;
        if (ph == 0) st_prologue(c);
        else {
            const int l = (ph - 1) / PH_PER_LAYER, j = (ph - 1) % PH_PER_LAYER;
            switch (j) {
                case 0: st_zgemm(c, l); break;
                case 1: st_rope(c); break;
                case 2: st_na(c, l); st_dil(c); st_pool(c, l); st_diff(c, l); break;
                case 3: st_merge(c, l); break;
                case 4: st_outgemm(c, l); break;
                case 5: st_ln1_router(c, l); break;
                case 6: st_pack(c, l); break;
                case 7: st_moe1(c, l); break;
                case 8: st_moe2(c, l); break;
                default: st_combine(c, l); break;
            }
        }
        if (ph + 1 < args.ph_hi) grid.sync();
    }
}

extern "C" void kernel_launch(void* const* d_in, const int* in_sizes, int n_in, void* d_out, int out_size, void* d_ws, size_t ws_size, hipStream_t stream) {
    static int grid_blocks = 0;
    if (grid_blocks == 0) {
        if (n_in != 23 || out_size != MT * DM || ws_size < WS_END) { fprintf(stderr, "kernel_launch: unexpected shapes n_in %d out %d ws %zu\n", n_in, out_size, ws_size); grid_blocks = -1; return; }
        int dev = 0, cus = 0, per_cu = 0;
        hipGetDevice(&dev);
        hipDeviceGetAttribute(&cus, hipDeviceAttributeMultiprocessorCount, dev);
        hipFuncSetAttribute((const void*)fwd, hipFuncAttributeMaxDynamicSharedMemorySize, LDS_BYTES);
        hipOccupancyMaxActiveBlocksPerMultiprocessor(&per_cu, (const void*)fwd, NTHR, LDS_BYTES);
        if (per_cu < 1) { fprintf(stderr, "kernel_launch: occupancy query says %d blocks per CU\n", per_cu); per_cu = 1; }
        (void)hipGetLastError();
        grid_blocks = cus * per_cu;
    }
    if (grid_blocks < 0) return;
    hipMemsetAsync((char*)d_ws + WS_CTL, 0, CTL_BYTES, stream);
    Args a{};
    for (int i = 0; i < 23; ++i) a.in[i] = (const float*)d_in[i];
    a.out = (float*)d_out; a.ws = (unsigned char*)d_ws;
    for (int i = 0; i < 4; ++i) a.invf8[i] = exp((double)i * (-2.0 * log(500000.0) / 8.0));
    for (int i = 0; i < 8; ++i) a.invf16[i] = exp((double)i * (-2.0 * log(500000.0) / 16.0));
    a.ph_lo = 0; a.ph_hi = N_PHASES;
    void* kargs[] = {&a};
    hipError_t e = hipLaunchCooperativeKernel((const void*)fwd, dim3(grid_blocks), dim3(NTHR), kargs, LDS_BYTES, stream);
    if (e != hipSuccess) fprintf(stderr, "cooperative launch failed: %s (grid %d)\n", hipGetErrorString(e), grid_blocks);
}
```

```cpp
#include <hip/hip_runtime.h>
#include <hip/hip_cooperative_groups.h>
#include <cstdio>
#include <cstdint>
#include <cmath>
namespace cg = cooperative_groups;

constexpr int NB = 4, SEQ = 4096, DM = 1024, MT = NB * SEQ, NLAYER = 2;
constexpr int ZC = 4096, GC = 4096, INC = 8192;
constexpr int C_NAQ = 0, C_NAK = 256, C_NAV = 512, C_DFQ = 768, C_DFK = 1024, C_DFV = 1280, C_PL = 1536, C_DL = 1792;
constexpr int NEXP = 32, DEXP = 512, CAP = 40960, NTILE = CAP / 256;
constexpr float LN_EPS = 1e-5f;
constexpr float ALPHA = 1.41421356237309515f;
constexpr float LOG2E = 1.4426950408889634f;
constexpr float QS_64 = 0.125f * LOG2E, QS_32 = 0.17677669529663687f * LOG2E;

typedef unsigned short bf16_t;
typedef float f32x4 __attribute__((ext_vector_type(4)));
typedef unsigned u32x4 __attribute__((ext_vector_type(4)));
typedef unsigned u32x2 __attribute__((ext_vector_type(2)));

constexpr size_t MiB = 1u << 20;
constexpr size_t WS_CTL = 0, CTL_BYTES = 1 * MiB;
constexpr size_t WS_ROPE8 = 1 * MiB;
constexpr size_t WS_ROPE16 = WS_ROPE8 + 2 * 4096 * 4 * 4;
constexpr size_t WS_EID = 2 * MiB;
constexpr size_t WS_GW = WS_EID + (size_t)MT * 2 * 4;
constexpr size_t WS_SLOT = WS_GW + (size_t)MT * 2 * 4;
constexpr size_t WS_TOK = WS_SLOT + (size_t)MT * 2 * 4;
constexpr size_t WS_TILEE = WS_TOK + (size_t)CAP * 4;
constexpr size_t WS_PWT = 3 * MiB;
constexpr size_t WS_RPBT = 3 * MiB + 65536;
constexpr size_t WS_HB = 4 * MiB;
constexpr size_t WS_YS = 36 * MiB;
constexpr size_t WS_ZMIX = 68 * MiB;
constexpr size_t WS_GATES = 196 * MiB;
constexpr size_t WS_YPRE = 196 * MiB;
constexpr size_t WS_HMID = 148 * MiB;
constexpr size_t WS_YEXP = 260 * MiB;
constexpr size_t WS_XS = 68 * MiB;
constexpr size_t WS_WIN = 376 * MiB;
constexpr size_t WS_WBR = 408 * MiB;
constexpr size_t WS_WOUT = 412 * MiB;
constexpr size_t WS_WGU = 416 * MiB;
constexpr size_t WS_WD = 480 * MiB;
constexpr size_t WS_END = 512 * MiB;
constexpr int CW_CNT = 1024;
constexpr int CW_CUR = 1024 + 64;

constexpr int LDS_BYTES = 147456;
constexpr int NTHR = 512;

struct Args {
    const float* in[23];
    float* out;
    unsigned char* ws;
    double invf8[4];
    double invf16[8];
    int ph_lo, ph_hi;
};

__device__ __forceinline__ float bf2f(bf16_t v) { return __uint_as_float(((unsigned)v) << 16); }
__device__ __forceinline__ unsigned f2bf(float f) { unsigned u = __float_as_uint(f); return (u + 0x7fffu + ((u >> 16) & 1u)) >> 16; }
__device__ __forceinline__ unsigned pk2(float lo, float hi) { return f2bf(lo) | (f2bf(hi) << 16); }
__device__ __forceinline__ float lo16(unsigned w) { return __uint_as_float(w << 16); }
__device__ __forceinline__ float hi16(unsigned w) { return __uint_as_float(w & 0xffff0000u); }
__device__ __forceinline__ float wave_sum(float v) {
#pragma unroll
    for (int o = 1; o < 64; o <<= 1) v += __shfl_xor(v, o);
    return v;
}
__device__ __forceinline__ void wave_ln_store(f32x4 (&v)[4], const float* g, const float* bta, float* hrow, bf16_t* hbrow, int lane) {
    float s = 0.f;
#pragma unroll
    for (int j = 0; j < 4; ++j) s += (v[j].x + v[j].y) + (v[j].z + v[j].w);
    const float mean = wave_sum(s) * (1.f / DM);
    float s2 = 0.f;
#pragma unroll
    for (int j = 0; j < 4; ++j) { v[j] = v[j] - mean; s2 += (v[j].x * v[j].x + v[j].y * v[j].y) + (v[j].z * v[j].z + v[j].w * v[j].w); }
    const float rstd = 1.f / sqrtf(wave_sum(s2) * (1.f / DM) + LN_EPS);
#pragma unroll
    for (int j = 0; j < 4; ++j) {
        const int c = 4 * lane + 256 * j;
        const f32x4 gg = *(const f32x4*)(g + c), bb = *(const f32x4*)(bta + c);
        f32x4 o = v[j] * rstd * gg + bb;
        v[j] = o;
        *(f32x4*)(hrow + c) = o;
        u32x2 w; w.x = pk2(o.x, o.y); w.y = pk2(o.z, o.w);
        *(u32x2*)(hbrow + c) = w;
    }
}

template <class AF, class BF, class EF>
__device__ __forceinline__ void ngemm_tile(float* sm, const int tid, int K, AF af, BF bf, EF ef) {
    float* As = sm;
    float* Bs = sm + 16 * 68;
    const int tx = tid & 31, ty = tid >> 5;
    f32x4 acc[4];
#pragma unroll
    for (int i = 0; i < 4; ++i) acc[i] = (f32x4){0.f, 0.f, 0.f, 0.f};
    const int arow = tid >> 3, ak = (tid & 7) * 2, bk = tid >> 5, bc = (tid & 31) * 4;
    for (int k0 = 0; k0 < K; k0 += 16) {
        const float a0 = af(arow, k0 + ak), a1 = af(arow, k0 + ak + 1);
        const f32x4 b = bf(k0 + bk, bc);
        __syncthreads();
        As[ak * 68 + arow] = a0; As[(ak + 1) * 68 + arow] = a1;
        *(f32x4*)(Bs + bk * 128 + bc) = b;
        __syncthreads();
#pragma unroll
        for (int kk = 0; kk < 16; ++kk) {
            const f32x4 a = *(const f32x4*)(As + kk * 68 + ty * 4);
            const f32x4 bb = *(const f32x4*)(Bs + kk * 128 + tx * 4);
            acc[0] += a.x * bb; acc[1] += a.y * bb; acc[2] += a.z * bb; acc[3] += a.w * bb;
        }
    }
#pragma unroll
    for (int i = 0; i < 4; ++i) ef(ty * 4 + i, tx * 4, acc[i]);
}


namespace pg8 {
#define PG8_LAS __attribute__((address_space(3)))
typedef short bf16x8 __attribute__((ext_vector_type(8)));
constexpr int BM = 256, BK = 64, HALF = 128, HTB = HALF * BK * 2, STAGE_BYTES = 8 * HTB, NXCD = 8, WGM = 8;
__host__ __device__ __forceinline__ int lds_byte(int r, int c) { const int st = (r >> 4) * 2 + (c >> 5), rr = r & 15, cc = c & 31, ob = rr * 64 + cc * 2; return st * 1024 + (ob ^ (((ob >> 9) & 1) << 5)); }
__host__ __device__ __forceinline__ void stage_rc(int b, int& R, int& C) { const int st = b / 1024, sb = b % 1024, swz = sb ^ (((sb >> 9) & 1) << 5); R = (st >> 1) * 16 + swz / 64; C = (st & 1) * 32 + (swz % 64) / 2; }
__host__ __device__ __forceinline__ int perm32(int rho) { const int n = rho >> 4, i = rho & 15; return 8 * (i >> 2) + 4 * n + (i & 3); }

struct Unit { int pm, pn; size_t a_off, b_off; };
struct Gemm { const bf16_t* A; const bf16_t* Bt; int lda, ldb, K; };

__device__ __forceinline__ unsigned cvt_pk_bf16(float lo, float hi) { unsigned r; asm volatile("v_cvt_pk_bf16_f32 %0, %1, %2" : "=v"(r) : "v"(lo), "v"(hi)); return r; }

struct TileOrder {
    int nM, nN, nwg, G, c;
    __device__ void init(int nM_, int nN_, int G_, int c_) { nM = nM_; nN = nN_; nwg = nM * nN; G = G_; c = c_; }
    __device__ bool tile(int i, int& pm, int& pn) const {
        const long L = (long)i * G + c; if (L >= nwg) return false;
        int wgid = (int)L; { const int q = nwg / NXCD, r = nwg % NXCD, xcd = wgid % NXCD, off = wgid / NXCD; wgid = (xcd < r ? xcd * (q + 1) : r * (q + 1) + (xcd - r) * q) + off; }
        const int nig = WGM * nN, gid = wgid / nig, fm = gid * WGM, gsz = (nM - fm) < WGM ? (nM - fm) : WGM;
        pm = fm + ((wgid % nig) % gsz); pn = (wgid % nig) / gsz; return true;
    }
};

template <class Epi, class Sched, bool ALIGN_EPI>
__device__ __forceinline__ void gemm_phase(PG8_LAS unsigned char* lds, const Gemm g, const Sched& S, const Epi& E, const int tid) {
    const int wid = __builtin_amdgcn_readfirstlane(tid >> 6), lane = tid & 63, wr = wid >> 2, wc = wid & 3, fr = lane & 15, fq = lane >> 4;
    int K = g.K, lda = g.lda, ldb = g.ldb; asm volatile("" : "+s"(K), "+s"(lda), "+s"(ldb));
    const int nt = K / BK;
    unsigned voffA[2], voffB[2];
#pragma unroll
    for (int i = 0; i < 2; ++i) { int R, C; stage_rc(tid * 16 + i * 8192, R, C); const int Rb = Epi::PERM ? ((R & ~31) + perm32(R & 31)) : R;
        voffA[i] = (unsigned)(R * lda + C) * 2u; voffB[i] = (unsigned)(Rb * ldb + C) * 2u; }
    const size_t kstep = (size_t)(BK * 2);
    const size_t hstepA = (size_t)HALF * lda * 2, hstepB = (size_t)HALF * ldb * 2;
    const unsigned ldsw = (unsigned)wid * 1024u;
    const int aoff = lds_byte(wr * 64 + fr, fq * 8), boff = lds_byte(wc * 32 + fr, fq * 8);
#define PG8_SA(b, h) (((b) * 2 + (h)) * HTB)
#define PG8_SB(b, h) ((4 + (b) * 2 + (h)) * HTB)
#define PG8_STAGE(bufoff, gbase, voff) do { _Pragma("unroll") for (int _i = 0; _i < 2; ++_i) \
        __builtin_amdgcn_global_load_lds((const unsigned*)((const char*)(gbase) + (voff)[_i]), (PG8_LAS unsigned*)(lds + (bufoff) + ldsw + _i * 8192), 16, 0, 0); } while (0)
#define PG8_LDA(dst, b, h) do { _Pragma("unroll") for (int m = 0; m < 4; ++m) _Pragma("unroll") for (int k = 0; k < 2; ++k) dst[m][k] = *(const PG8_LAS bf16x8*)(lds + PG8_SA(b, h) + aoff + m * 2048 + k * 1024); } while (0)
#define PG8_LDB(dst, b, h) do { _Pragma("unroll") for (int n = 0; n < 2; ++n) _Pragma("unroll") for (int k = 0; k < 2; ++k) dst[n][k] = *(const PG8_LAS bf16x8*)(lds + PG8_SB(b, h) + boff + n * 2048 + k * 1024); } while (0)
#define PG8_MMA(ai, bj, At, Bt) do { __builtin_amdgcn_s_setprio(1); _Pragma("unroll") for (int m = 0; m < 4; ++m) _Pragma("unroll") for (int n = 0; n < 2; ++n) _Pragma("unroll") for (int k = 0; k < 2; ++k) \
        acc[ai][bj][m][n] = __builtin_amdgcn_mfma_f32_16x16x32_bf16(Bt[n][k], At[m][k], acc[ai][bj][m][n], 0, 0, 0); __builtin_amdgcn_s_setprio(0); } while (0)
#define PG8_WAIT_V(n) asm volatile("s_waitcnt vmcnt(" #n ")" ::: "memory")
#define PG8_WAIT_L(n) asm volatile("s_waitcnt lgkmcnt(" #n ")" ::: "memory")
#define PG8_BAR __builtin_amdgcn_s_barrier()
#define PG8_SCHED __builtin_amdgcn_sched_barrier(0)
    Unit cur, nxt; int ui = 0;
    if (!S.next(0, cur)) return;
    f32x4 acc[2][2][4][2];
#pragma unroll
    for (int a = 0; a < 2; ++a)
#pragma unroll
        for (int b = 0; b < 2; ++b)
#pragma unroll
            for (int m = 0; m < 4; ++m)
#pragma unroll
                for (int n = 0; n < 2; ++n) acc[a][b][m][n] = (f32x4){0.f, 0.f, 0.f, 0.f};
    bf16x8 At[4][2], B0[2][2], B1[2][2];
    const char* cA = (const char*)g.A + cur.a_off; const char* cB = (const char*)g.Bt + cur.b_off;
    PG8_STAGE(PG8_SB(0, 0), cB, voffB); PG8_STAGE(PG8_SB(0, 1), cB + hstepB, voffB); PG8_STAGE(PG8_SA(0, 0), cA, voffA); PG8_STAGE(PG8_SA(0, 1), cA + hstepA, voffA);
    if (wr == 1) PG8_BAR;
    PG8_WAIT_V(2); PG8_BAR;
    PG8_STAGE(PG8_SB(1, 0), cB + kstep, voffB); PG8_STAGE(PG8_SA(1, 0), cA + kstep, voffA); PG8_STAGE(PG8_SB(1, 1), cB + hstepB + kstep, voffB);
    PG8_WAIT_V(6); PG8_BAR;
    for (;;) {
        const bool has_next = S.next(ui + 1, nxt);
        const char* nA = has_next ? (const char*)g.A + nxt.a_off : cA; const char* nB = has_next ? (const char*)g.Bt + nxt.b_off : cB;
        for (int t = 0; t < nt; t += 2) {
            const bool last = (t == nt - 2);
            const char* a1 = cA + (size_t)(t + 1) * kstep;
            const char* a2 = last ? nA : cA + (size_t)(t + 2) * kstep; const char* b2 = last ? nB : cB + (size_t)(t + 2) * kstep;
            const char* a3 = a2 + kstep; const char* b3 = b2 + kstep;
            PG8_LDB(B0, 0, 0); PG8_LDB(B1, 0, 1); PG8_SCHED; PG8_LDA(At, 0, 0); PG8_STAGE(PG8_SA(1, 1), a1 + hstepA, voffA);
            PG8_WAIT_V(8); PG8_WAIT_L(0); PG8_BAR; PG8_MMA(0, 0, At, B0); PG8_MMA(0, 1, At, B1); PG8_BAR; PG8_SCHED;
            PG8_LDA(At, 0, 1); PG8_STAGE(PG8_SB(0, 0), b2, voffB); PG8_STAGE(PG8_SB(0, 1), b2 + hstepB, voffB); PG8_STAGE(PG8_SA(0, 0), a2, voffA);
            PG8_WAIT_V(8); PG8_WAIT_L(0); PG8_BAR; PG8_MMA(1, 0, At, B0); PG8_MMA(1, 1, At, B1); PG8_BAR; PG8_SCHED;
            PG8_LDB(B0, 1, 0); PG8_LDB(B1, 1, 1); PG8_SCHED; PG8_LDA(At, 1, 0); PG8_STAGE(PG8_SA(0, 1), a2 + hstepA, voffA);
            PG8_WAIT_V(8); PG8_WAIT_L(0); PG8_BAR; PG8_MMA(0, 0, At, B0); PG8_MMA(0, 1, At, B1); PG8_BAR; PG8_SCHED;
            PG8_LDA(At, 1, 1); PG8_STAGE(PG8_SB(1, 0), b3, voffB); PG8_STAGE(PG8_SB(1, 1), b3 + hstepB, voffB); PG8_STAGE(PG8_SA(1, 0), a3, voffA);
            PG8_WAIT_V(8); PG8_WAIT_L(0); PG8_BAR; PG8_MMA(1, 0, At, B0); PG8_MMA(1, 1, At, B1); PG8_BAR; PG8_SCHED;
        }
        if constexpr (ALIGN_EPI) { if (wr == 0) PG8_BAR; }
        E(acc, cur, wr, wc, fr, fq);
        if (!has_next) break;
#pragma unroll
        for (int a = 0; a < 2; ++a)
#pragma unroll
            for (int b = 0; b < 2; ++b)
#pragma unroll
                for (int m = 0; m < 4; ++m)
#pragma unroll
                    for (int n = 0; n < 2; ++n) acc[a][b][m][n] = (f32x4){0.f, 0.f, 0.f, 0.f};
        cur = nxt; cA = nA; cB = nB; ++ui;
        if constexpr (ALIGN_EPI) { if (wr == 1) PG8_BAR; }
    }
    PG8_WAIT_V(0);
    if constexpr (!ALIGN_EPI) { if (wr == 0) PG8_BAR; }
    PG8_BAR;
#undef PG8_SA
#undef PG8_SB
#undef PG8_STAGE
#undef PG8_LDA
#undef PG8_LDB
#undef PG8_MMA
#undef PG8_WAIT_V
#undef PG8_WAIT_L
#undef PG8_BAR
#undef PG8_SCHED
}
}
#define LAS __attribute__((address_space(3)))
#define GAS __attribute__((address_space(1)))

struct Ctx {
    const Args* a; int tid, bid, nblk; unsigned char* ws; float* h; LAS unsigned char* ldsp;
    __device__ __forceinline__ int lane() const { return tid & 63; }
    __device__ __forceinline__ int wave() const { return tid >> 6; }
    __device__ __forceinline__ int gw() const { return bid * (NTHR / 64) + (tid >> 6); }
    __device__ __forceinline__ int ngw() const { return nblk * (NTHR / 64); }
    __device__ __forceinline__ long gtid() const { return (long)bid * NTHR + tid; }
    __device__ __forceinline__ long ngt() const { return (long)nblk * NTHR; }
    __device__ __forceinline__ float* sm() const { return (float*)ldsp; }
};
#define c_hb     ((bf16_t*)(c.ws + WS_HB))
#define c_merged ((bf16_t*)(c.ws + WS_HB))
#define c_ys     ((bf16_t*)(c.ws + WS_YS))
#define c_zmix   ((bf16_t*)(c.ws + WS_ZMIX))
#define c_gates  ((bf16_t*)(c.ws + WS_GATES))
#define c_ypre   ((float*)(c.ws + WS_YPRE))
#define c_hmid   ((bf16_t*)(c.ws + WS_HMID))
#define c_yexp   ((bf16_t*)(c.ws + WS_YEXP))
#define c_eid    ((int*)(c.ws + WS_EID))
#define c_gwt    ((float*)(c.ws + WS_GW))
#define c_slot   ((int*)(c.ws + WS_SLOT))
#define c_tok    ((int*)(c.ws + WS_TOK))
#define c_tile_e ((int*)(c.ws + WS_TILEE))
#define c_ctl    ((unsigned*)(c.ws + WS_CTL))
#define c_rc8    ((float*)(c.ws + WS_ROPE8))
#define c_rs8    ((float*)(c.ws + WS_ROPE8) + 4096 * 4)
#define c_rc16   ((float*)(c.ws + WS_ROPE16))
#define c_rs16   ((float*)(c.ws + WS_ROPE16) + 4096 * 8)
#define c_pwt    ((bf16_t*)(c.ws + WS_PWT))
#define c_rpbt   ((float*)(c.ws + WS_RPBT))
#define c_xs     ((bf16_t*)(c.ws + WS_XS))
#define c_win    ((bf16_t*)(c.ws + WS_WIN))
#define c_wbr    ((bf16_t*)(c.ws + WS_WBR))
#define c_wout   ((bf16_t*)(c.ws + WS_WOUT))
#define c_wgu    ((bf16_t*)(c.ws + WS_WGU))
#define c_wd     ((bf16_t*)(c.ws + WS_WD))

__device__ __forceinline__ void st_prologue(Ctx& c) {
    const Args& A = *c.a;
    for (long i = c.gtid(); i < 4096; i += c.ngt()) {
        const int pos = (int)i;
#pragma unroll
        for (int j = 0; j < 12; ++j) {
            const double f = j < 4 ? A.invf8[j < 4 ? j : 0] : A.invf16[j < 4 ? 0 : j - 4];
            const double ang = (double)pos * f;
            const double kk = __builtin_rint(ang * 0.15915494309189535);
            const float r = (float)(ang - kk * 6.283185307179586);
            const float cs = cosf(r), sn = sinf(r);
            if (j < 4) { c_rc8[pos * 4 + j] = cs; c_rs8[pos * 4 + j] = sn; }
            else { c_rc16[pos * 8 + j - 4] = cs; c_rs16[pos * 8 + j - 4] = sn; }
        }
    }
    for (long i = c.gtid(); i < 2 * 4 * 64 * 64; i += c.ngt()) { const int cc = (int)(i & 63), e = (int)((i >> 6) & 63), lg = (int)(i >> 12);
        c_pwt[i] = (bf16_t)f2bf(A.in[8][((size_t)lg * 64 + cc) * 64 + e]); }
    for (long i = c.gtid(); i < 2 * 4 * 15 * 31; i += c.ngt()) c_rpbt[i] = A.in[5][i] * LOG2E;
    const float* x = A.in[0];
    for (int m = c.gw(); m < MT; m += c.ngw()) {
        f32x4 v[4];
#pragma unroll
        for (int j = 0; j < 4; ++j) v[j] = *(const f32x4*)(x + (size_t)m * DM + 4 * c.lane() + 256 * j);
        wave_ln_store(v, A.in[1], A.in[2], c.h + (size_t)m * DM, c_hb + (size_t)m * DM, c.lane());
    }
}

__device__ __forceinline__ void st_zgemm(Ctx& c, int l) {
    const float* W = c.a->in[3] + (size_t)l * DM * INC;
    const float* bg = c.a->in[4] + (size_t)l * GC;
    for (int t = c.bid; t < (MT / 64) * (INC / 128); t += c.nblk) {
        const int tn = t % (INC / 128), tm = t / (INC / 128), m0 = tm * 64, n0 = tn * 128;
        const bf16_t* hb = c_hb; bf16_t* zmix = c_zmix; bf16_t* gates = c_gates;
        ngemm_tile(c.sm(), c.tid, DM,
            [&](int r, int k) { return bf2f(hb[(size_t)(m0 + r) * DM + k]); },
            [&](int k, int c4) { return *(const f32x4*)(W + (size_t)k * INC + n0 + c4); },
            [&](int r, int c4, f32x4 v) {
                const int col = n0 + c4; const size_t row = (size_t)(m0 + r);
                if (col < ZC) { u32x2 w; w.x = pk2(v.x, v.y); w.y = pk2(v.z, v.w); *(u32x2*)(zmix + row * ZC + col) = w; }
                else { const f32x4 b = *(const f32x4*)(bg + col - ZC); f32x4 s;
                    s.x = 1.f / (1.f + __expf(-(v.x + b.x))); s.y = 1.f / (1.f + __expf(-(v.y + b.y)));
                    s.z = 1.f / (1.f + __expf(-(v.z + b.z))); s.w = 1.f / (1.f + __expf(-(v.w + b.w)));
                    u32x2 w; w.x = pk2(s.x, s.y); w.y = pk2(s.z, s.w); *(u32x2*)(gates + row * GC + col - ZC) = w; }
            });
    }
}


__device__ __forceinline__ void transpose_item(const float* W, int K, int N, bf16_t* WT, int kb, int n0, size_t out_row0, LAS float* scr, int lane) {
    const int k0 = 64 * kb;
#pragma unroll 8
    for (int i = 0; i < 32; ++i) { const int kk = 2 * i + (lane >> 5); scr[kk * 33 + (lane & 31)] = W[(size_t)(k0 + kk) * N + n0 + (lane & 31)]; }
    asm volatile("s_waitcnt lgkmcnt(0)" ::: "memory");
    const int cc = lane & 7;
#pragma unroll
    for (int j = 0; j < 4; ++j) { const int n = (lane >> 3) + 8 * j; const LAS float* sp = scr + (8 * cc) * 33 + n;
        u32x4 o; o.x = pk2(sp[0 * 33], sp[1 * 33]); o.y = pk2(sp[2 * 33], sp[3 * 33]); o.z = pk2(sp[4 * 33], sp[5 * 33]); o.w = pk2(sp[6 * 33], sp[7 * 33]);
        *(u32x4*)(WT + (out_row0 + n) * K + k0 + 8 * cc) = o; }
    asm volatile("s_waitcnt lgkmcnt(0)" ::: "memory");
}
__device__ __forceinline__ void st_convert_common(Ctx& c) {
    LAS float* scr = (LAS float*)(c.ldsp + c.wave() * 16384);
    const float* w_in = c.a->in[3]; const float* w_br = c.a->in[10]; const float* w_out = c.a->in[11];
    constexpr int I_IN = 2 * 16 * 256, I_BR = 8 * 128, I_OUT = 2 * 512;
    for (int it = c.gw(); it < I_IN + I_BR + I_OUT; it += c.ngw()) {
        int r = it;
        if (r < I_IN) { const int l = r / 4096, q = r % 4096, kb = q / 256, nb = q % 256;
            transpose_item(w_in + (size_t)l * DM * INC, DM, INC, c_win + (size_t)l * INC * DM, kb, nb * 32, (size_t)nb * 32, scr, c.lane()); continue; }
        r -= I_IN;
        if (r < I_BR) { const int mtx = r / 128, q = r % 128, kb = q / 32, nb = q % 32;
            transpose_item(w_br + (size_t)mtx * 256 * DM, 256, DM, c_wbr, kb, nb * 32, (size_t)mtx * 1024 + nb * 32, scr, c.lane()); continue; }
        r -= I_BR;
        { const int l = r / 512, q = r % 512, kb = q / 32, nb = q % 32;
            transpose_item(w_out + (size_t)l * DM * DM, DM, DM, c_wout + (size_t)l * DM * DM, kb, nb * 32, (size_t)nb * 32, scr, c.lane()); }
    }
}
__device__ __forceinline__ void st_convert_experts(Ctx& c, int l) {
    LAS float* scr = (LAS float*)(c.ldsp + c.wave() * 16384);
    const float* WG = c.a->in[18] + (size_t)l * NEXP * DM * DEXP; const float* WU = c.a->in[19] + (size_t)l * NEXP * DM * DEXP; const float* WD = c.a->in[20] + (size_t)l * NEXP * DEXP * DM;
    constexpr int I_GU = NEXP * 2 * 256, I_D = NEXP * 256;
    for (int it = c.gw(); it < I_GU + I_D; it += c.ngw()) {
        int r = it;
        if (r < I_GU) { const int e = r / 512, q = r % 512, which = q / 256, q2 = q % 256, kb = q2 / 16, nb = q2 % 16, n0 = nb * 32;
            const float* W = (which ? WU : WG) + (size_t)e * DM * DEXP;
            transpose_item(W, DM, DEXP, c_wgu, kb, n0, (size_t)e * 1024 + (n0 / 128) * 256 + which * 128 + (n0 % 128), scr, c.lane()); continue; }
        r -= I_GU;
        { const int e = r / 256, q = r % 256, kb = q / 32, nb = q % 32;
            transpose_item(WD + (size_t)e * DEXP * DM, DEXP, DM, c_wd, kb, nb * 32, (size_t)e * 1024 + nb * 32, scr, c.lane()); }
    }
}

struct EpiZ {
    static constexpr bool PERM = true;
    bf16_t* zmix; bf16_t* gates; const float* bgate; const float* rc8; const float* rs8; const float* rc16; const float* rs16;
    __device__ __forceinline__ void operator()(const f32x4 (&acc)[2][2][4][2], const pg8::Unit& u, int wr, int wc, int fr, int fq) const {
        const int row0 = u.pm * 256 + wr * 64 + fr, pn = u.pn;
        if (pn >= 16) {
            const int col0 = (pn - 16) * 256 + wc * 32 + 8 * fq;
            f32x4 bv[2][2];
#pragma unroll
            for (int bj = 0; bj < 2; ++bj)
#pragma unroll
                for (int n = 0; n < 2; ++n) bv[bj][n] = *(const f32x4*)(bgate + col0 + bj * 128 + 4 * n);
#pragma unroll
            for (int ai = 0; ai < 2; ++ai)
#pragma unroll
                for (int m = 0; m < 4; ++m) { bf16_t* rowp = gates + (size_t)(row0 + ai * 128 + m * 16) * GC + col0;
#pragma unroll
                    for (int bj = 0; bj < 2; ++bj) { const f32x4 v0 = acc[ai][bj][m][0] + bv[bj][0], v1 = acc[ai][bj][m][1] + bv[bj][1];
                        u32x4 w;
                        w.x = pg8::cvt_pk_bf16(1.f / (1.f + __expf(-v0.x)), 1.f / (1.f + __expf(-v0.y))); w.y = pg8::cvt_pk_bf16(1.f / (1.f + __expf(-v0.z)), 1.f / (1.f + __expf(-v0.w)));
                        w.z = pg8::cvt_pk_bf16(1.f / (1.f + __expf(-v1.x)), 1.f / (1.f + __expf(-v1.y))); w.w = pg8::cvt_pk_bf16(1.f / (1.f + __expf(-v1.z)), 1.f / (1.f + __expf(-v1.w)));
                        *(u32x4*)(rowp + bj * 128) = w; } }
        } else {
            const int col0 = pn * 256 + wc * 32 + 8 * fq;
            const float qs = (pn == 0 || pn == 7 || pn == 10 || pn == 13) ? QS_64 : (pn == 3 ? QS_32 : 1.f);
            const bool r8 = (pn == 3 || pn == 4);
            const bool r16 = (pn >= 7) && (((pn - 7) % 3) != 2) && ((wc & 1) == 0);
#pragma unroll
            for (int ai = 0; ai < 2; ++ai)
#pragma unroll
                for (int m = 0; m < 4; ++m) { const int row = row0 + ai * 128 + m * 16, pos = row & (SEQ - 1); bf16_t* rowp = zmix + (size_t)row * ZC + col0;
#pragma unroll
                    for (int bj = 0; bj < 2; ++bj) { f32x4 v0 = acc[ai][bj][m][0], v1 = acc[ai][bj][m][1];
                        if (r8) {
                            if (fq == 0) { const f32x4 cs = *(const f32x4*)(rc8 + pos * 4), sn = *(const f32x4*)(rs8 + pos * 4);
                                const f32x4 n0 = v0 * cs - v1 * sn, n1 = v0 * sn + v1 * cs; v0 = n0; v1 = n1; }
                        } else if (r16) {
                            f32x4 o0, o1;
                            o0.x = __shfl_xor(v0.x, 16); o0.y = __shfl_xor(v0.y, 16); o0.z = __shfl_xor(v0.z, 16); o0.w = __shfl_xor(v0.w, 16);
                            o1.x = __shfl_xor(v1.x, 16); o1.y = __shfl_xor(v1.y, 16); o1.z = __shfl_xor(v1.z, 16); o1.w = __shfl_xor(v1.w, 16);
                            if (fq < 2) { const f32x4 c0 = *(const f32x4*)(rc16 + pos * 8), c1 = *(const f32x4*)(rc16 + pos * 8 + 4), s0 = *(const f32x4*)(rs16 + pos * 8), s1 = *(const f32x4*)(rs16 + pos * 8 + 4);
                                if (fq == 0) { v0 = v0 * c0 - o0 * s0; v1 = v1 * c1 - o1 * s1; }
                                else { v0 = o0 * s0 + v0 * c0; v1 = o1 * s1 + v1 * c1; } }
                        }
                        v0 = v0 * qs; v1 = v1 * qs;
                        u32x4 w; w.x = pg8::cvt_pk_bf16(v0.x, v0.y); w.y = pg8::cvt_pk_bf16(v0.z, v0.w); w.z = pg8::cvt_pk_bf16(v1.x, v1.y); w.w = pg8::cvt_pk_bf16(v1.z, v1.w);
                        *(u32x4*)(rowp + bj * 128) = w; } }
        }
    }
};
struct ZSched {
    pg8::TileOrder T;
    __device__ __forceinline__ bool next(int i, pg8::Unit& u) const { int pm, pn; if (!T.tile(i, pm, pn)) return false; u.pm = pm; u.pn = pn;
        u.a_off = (size_t)pm * 256 * DM * 2; u.b_off = (size_t)pn * 256 * DM * 2; return true; }
};
__device__ __forceinline__ void st_zgemm_fast(Ctx& c, int l) {
    pg8::Gemm g{c_hb, c_win + (size_t)l * INC * DM, DM, DM, DM};
    ZSched S; S.T.init(MT / 256, INC / 256, c.nblk, c.bid);
    EpiZ E{c_zmix, c_gates, c.a->in[4] + (size_t)l * GC, c_rc8, c_rs8, c_rc16, c_rs16};
    pg8::gemm_phase<EpiZ, ZSched, true>(c.ldsp, g, S, E, c.tid);
}


struct EpiBr {
    static constexpr bool PERM = true;
    bf16_t* gp; const bf16_t* gates;
    __device__ __forceinline__ void operator()(const f32x4 (&acc)[2][2][4][2], const pg8::Unit& u, int wr, int wc, int fr, int fq) const {
        const int row0 = u.pm * 256 + wr * 64 + fr, col0 = u.pn * 256 + wc * 32 + 8 * fq;
#pragma unroll
        for (int ai = 0; ai < 2; ++ai)
#pragma unroll
            for (int m = 0; m < 4; ++m) { const size_t off = (size_t)(row0 + ai * 128 + m * 16) * GC + col0;
#pragma unroll
                for (int bj = 0; bj < 2; ++bj) { const u32x4 g = *(const u32x4*)(gates + off + bj * 128); const f32x4 v0 = acc[ai][bj][m][0], v1 = acc[ai][bj][m][1];
                    u32x4 w; w.x = pg8::cvt_pk_bf16(v0.x * lo16(g.x), v0.y * hi16(g.x)); w.y = pg8::cvt_pk_bf16(v0.z * lo16(g.y), v0.w * hi16(g.y));
                    w.z = pg8::cvt_pk_bf16(v1.x * lo16(g.z), v1.y * hi16(g.z)); w.w = pg8::cvt_pk_bf16(v1.z * lo16(g.w), v1.w * hi16(g.w));
                    *(u32x4*)(gp + off + bj * 128) = w; }
                asm volatile("" ::: "memory"); }
    }
};
struct BrSched {
    pg8::TileOrder T;
    __device__ __forceinline__ bool next(int i, pg8::Unit& u) const { int pm, pn; if (!T.tile(i, pm, pn)) return false; u.pm = pm; u.pn = pn;
        u.a_off = (size_t)pm * 256 * DM * 2 + (size_t)(pn >> 2) * 256 * 2; u.b_off = (size_t)pn * 256 * 256 * 2; return true; }
};
__device__ __forceinline__ void st_branch_fast(Ctx& c, int l) {
    pg8::Gemm g{c_ys, c_wbr + (size_t)l * 4096 * 256, DM, 256, 256};
    BrSched S; S.T.init(MT / 256, 16, c.nblk, c.bid);
    EpiBr E{c_zmix, c_gates};
    pg8::gemm_phase<EpiBr, BrSched, true>(c.ldsp, g, S, E, c.tid);
}
__device__ __forceinline__ void st_sum4(Ctx& c) {
    const bf16_t* gp = c_zmix; bf16_t* mg = c_merged;
    for (long i = c.gtid(); i < (long)MT * 128; i += c.ngt()) {
        const size_t t = (size_t)(i >> 7); const int d = (int)(i & 127) * 8;
        const u32x4 a = *(const u32x4*)(gp + t * GC + d), b = *(const u32x4*)(gp + t * GC + 1024 + d), cc = *(const u32x4*)(gp + t * GC + 2048 + d), dd = *(const u32x4*)(gp + t * GC + 3072 + d);
        u32x4 w;
        w.x = pk2((lo16(a.x) + lo16(b.x)) + (lo16(cc.x) + lo16(dd.x)), (hi16(a.x) + hi16(b.x)) + (hi16(cc.x) + hi16(dd.x)));
        w.y = pk2((lo16(a.y) + lo16(b.y)) + (lo16(cc.y) + lo16(dd.y)), (hi16(a.y) + hi16(b.y)) + (hi16(cc.y) + hi16(dd.y)));
        w.z = pk2((lo16(a.z) + lo16(b.z)) + (lo16(cc.z) + lo16(dd.z)), (hi16(a.z) + hi16(b.z)) + (hi16(cc.z) + hi16(dd.z)));
        w.w = pk2((lo16(a.w) + lo16(b.w)) + (lo16(cc.w) + lo16(dd.w)), (hi16(a.w) + hi16(b.w)) + (hi16(cc.w) + hi16(dd.w)));
        *(u32x4*)(mg + t * DM + d) = w;
    }
}
struct EpiOut {
    static constexpr bool PERM = false;
    const float* h; float* ypre;
    __device__ __forceinline__ void operator()(const f32x4 (&acc)[2][2][4][2], const pg8::Unit& u, int wr, int wc, int fr, int fq) const {
        const int row0 = u.pm * 256 + wr * 64 + fr, col0 = u.pn * 256 + wc * 32 + 4 * fq;
#pragma unroll
        for (int ai = 0; ai < 2; ++ai)
#pragma unroll
            for (int m = 0; m < 4; ++m) { const size_t off = (size_t)(row0 + ai * 128 + m * 16) * DM + col0;
#pragma unroll
                for (int bj = 0; bj < 2; ++bj)
#pragma unroll
                    for (int n = 0; n < 2; ++n) { const f32x4 hv = *(const f32x4*)(h + off + bj * 128 + n * 16); *(f32x4*)(ypre + off + bj * 128 + n * 16) = ALPHA * hv + acc[ai][bj][m][n]; }
                asm volatile("" ::: "memory"); }
    }
};
struct OutSched {
    pg8::TileOrder T;
    __device__ __forceinline__ bool next(int i, pg8::Unit& u) const { int pm, pn; if (!T.tile(i, pm, pn)) return false; u.pm = pm; u.pn = pn;
        u.a_off = (size_t)pm * 256 * DM * 2; u.b_off = (size_t)pn * 256 * DM * 2; return true; }
};
__device__ __forceinline__ void st_outgemm_fast(Ctx& c, int l) {
    pg8::Gemm g{c_merged, c_wout + (size_t)l * DM * DM, DM, DM, DM};
    OutSched S; S.T.init(MT / 256, DM / 256, c.nblk, c.bid);
    EpiOut E{c.h, c_ypre};
    pg8::gemm_phase<EpiOut, OutSched, true>(c.ldsp, g, S, E, c.tid);
}
__device__ __forceinline__ void st_pack_fast(Ctx& c, int l) {
    unsigned* cnt = c_ctl + CW_CNT + l * 32; unsigned* cur = c_ctl + CW_CUR + l * 32;
    int* offs = (int*)c.sm();
    if (c.tid == 0) { int o = 0; for (int e = 0; e < NEXP; ++e) { offs[e] = o; const int n = (int)__hip_atomic_load(cnt + e, __ATOMIC_RELAXED, __HIP_MEMORY_SCOPE_AGENT); o += (n + 255) / 256 * 256; } offs[32] = o; }
    __syncthreads();
    if (c.bid == 0) {
        for (int i = c.tid; i <= NTILE; i += NTHR) { const int row = i * 256; int e = -1;
            if (i == NTILE) e = offs[32] / 256;
            else if (row < offs[32]) { e = 0; for (int q = 1; q < NEXP; ++q) if (row >= offs[q]) e = q; }
            c_tile_e[i] = e; }
    }
    const int lane = c.lane();
    for (int i = c.gw(); i < MT * 2; i += c.ngw()) {
        int pos = 0;
        if (lane == 0) { const int e = c_eid[i]; pos = offs[e] + (int)atomicAdd(cur + e, 1u); c_slot[i] = pos; c_tok[pos] = i >> 1; }
        pos = __builtin_amdgcn_readfirstlane(pos);
        const u32x4* src = (const u32x4*)(c_hb + (size_t)(i >> 1) * DM); u32x4* dst = (u32x4*)(c_xs + (size_t)pos * DM);
        const u32x4 a = src[lane], b = src[lane + 64];
        dst[lane] = a; dst[lane + 64] = b;
    }
    __syncthreads();
}
struct MoeSched {
    const int* tile_e; int G, c; int lda_bytes_tile, b_tile_bytes, b_exp_bytes;
    __device__ __forceinline__ bool next(int i, pg8::Unit& u) const {
        const int L = i * G + c, pm = L >> 2, pn = L & 3;
        if (pm >= NTILE) return false;
        const int e = __builtin_amdgcn_readfirstlane(tile_e[pm]);
        if (e < 0) return false;
        u.pm = pm; u.pn = pn; u.a_off = (size_t)pm * lda_bytes_tile; u.b_off = (size_t)e * b_exp_bytes + (size_t)pn * b_tile_bytes; return true; }
};
__device__ __forceinline__ float silu_f(float x) { return x / (1.f + __expf(-x)); }
struct EpiMoe1 {
    static constexpr bool PERM = true;
    bf16_t* hmid;
    __device__ __forceinline__ void operator()(const f32x4 (&acc)[2][2][4][2], const pg8::Unit& u, int wr, int wc, int fr, int fq) const {
        const int row0 = u.pm * 256 + wr * 64 + fr, col0 = u.pn * 128 + wc * 32 + 8 * fq;
#pragma unroll
        for (int ai = 0; ai < 2; ++ai)
#pragma unroll
            for (int m = 0; m < 4; ++m) { const f32x4 g0 = acc[ai][0][m][0], g1 = acc[ai][0][m][1], u0 = acc[ai][1][m][0], u1 = acc[ai][1][m][1];
                u32x4 w; w.x = pg8::cvt_pk_bf16(silu_f(g0.x) * u0.x, silu_f(g0.y) * u0.y); w.y = pg8::cvt_pk_bf16(silu_f(g0.z) * u0.z, silu_f(g0.w) * u0.w);
                w.z = pg8::cvt_pk_bf16(silu_f(g1.x) * u1.x, silu_f(g1.y) * u1.y); w.w = pg8::cvt_pk_bf16(silu_f(g1.z) * u1.z, silu_f(g1.w) * u1.w);
                *(u32x4*)(hmid + (size_t)(row0 + ai * 128 + m * 16) * DEXP + col0) = w; }
    }
};
struct EpiMoe2 {
    static constexpr bool PERM = true;
    bf16_t* yexp;
    __device__ __forceinline__ void operator()(const f32x4 (&acc)[2][2][4][2], const pg8::Unit& u, int wr, int wc, int fr, int fq) const {
        const int row0 = u.pm * 256 + wr * 64 + fr, col0 = u.pn * 256 + wc * 32 + 8 * fq;
#pragma unroll
        for (int ai = 0; ai < 2; ++ai)
#pragma unroll
            for (int m = 0; m < 4; ++m)
#pragma unroll
                for (int bj = 0; bj < 2; ++bj) { const f32x4 v0 = acc[ai][bj][m][0], v1 = acc[ai][bj][m][1];
                    u32x4 w; w.x = pg8::cvt_pk_bf16(v0.x, v0.y); w.y = pg8::cvt_pk_bf16(v0.z, v0.w); w.z = pg8::cvt_pk_bf16(v1.x, v1.y); w.w = pg8::cvt_pk_bf16(v1.z, v1.w);
                    *(u32x4*)(yexp + (size_t)(row0 + ai * 128 + m * 16) * DM + col0 + bj * 128) = w; }
    }
};
__device__ __forceinline__ void st_moe1_fast(Ctx& c) {
    pg8::Gemm g{c_xs, c_wgu, DM, DM, DM};
    MoeSched S{c_tile_e, c.nblk, c.bid, 256 * DM * 2, 256 * DM * 2, 1024 * DM * 2};
    EpiMoe1 E{c_hmid};
    pg8::gemm_phase<EpiMoe1, MoeSched, true>(c.ldsp, g, S, E, c.tid);
}
__device__ __forceinline__ void st_moe2_fast(Ctx& c) {
    pg8::Gemm g{c_hmid, c_wd, DEXP, DEXP, DEXP};
    MoeSched S{c_tile_e, c.nblk, c.bid, 256 * DEXP * 2, 256 * DEXP * 2, 1024 * DEXP * 2};
    EpiMoe2 E{c_yexp};
    pg8::gemm_phase<EpiMoe2, MoeSched, true>(c.ldsp, g, S, E, c.tid);
}


typedef short bf16x8 __attribute__((ext_vector_type(8)));
typedef short s16x4 __attribute__((ext_vector_type(4)));
typedef float f32x16 __attribute__((ext_vector_type(16)));
#define MFMA32(a, b, c) __builtin_amdgcn_mfma_f32_32x32x16_bf16((a), (b), (c), 0, 0, 0)
#define SM_THR 8.0f
#define MASKV (-30000.0f)
__device__ __forceinline__ int crow(int r, int hi) { return (r & 3) + 8 * (r >> 2) + 4 * hi; }
__device__ __forceinline__ s16x4 vtr(const LAS char* p) { return __builtin_bit_cast(s16x4, __builtin_amdgcn_ds_read_tr16_b64_v4i16((LAS s16x4*)p)); }
__device__ __forceinline__ bf16x8 vfrag(const LAS char* p) { const s16x4 lo = vtr(p), hi = vtr(p + 512); return (bf16x8){lo[0], lo[1], lo[2], lo[3], hi[0], hi[1], hi[2], hi[3]}; }
__device__ __forceinline__ int vlane_off(int lane) { return (4 * (lane >> 5) + ((lane & 15) >> 2)) * 64 + (16 * ((lane >> 4) & 1) + 4 * (lane & 3)) * 2; }
__device__ __forceinline__ float max16(const f32x16& p) {
    float a = fmaxf(fmaxf(p[0], p[1]), fmaxf(p[2], p[3])), b = fmaxf(fmaxf(p[4], p[5]), fmaxf(p[6], p[7]));
    float cc = fmaxf(fmaxf(p[8], p[9]), fmaxf(p[10], p[11])), d = fmaxf(fmaxf(p[12], p[13]), fmaxf(p[14], p[15]));
    return fmaxf(fmaxf(a, b), fmaxf(cc, d));
}
__device__ __forceinline__ bf16x8 pack8(const f32x16& p, int s) {
    u32x4 w; w.x = pg8::cvt_pk_bf16(p[8 * s + 0], p[8 * s + 1]); w.y = pg8::cvt_pk_bf16(p[8 * s + 2], p[8 * s + 3]);
    w.z = pg8::cvt_pk_bf16(p[8 * s + 4], p[8 * s + 5]); w.w = pg8::cvt_pk_bf16(p[8 * s + 6], p[8 * s + 7]);
    return __builtin_bit_cast(bf16x8, w);
}
__device__ __forceinline__ float exp2_sum16(f32x16& p) {
    float s = 0.f;
#pragma unroll
    for (int r = 0; r < 16; ++r) { p[r] = __builtin_amdgcn_exp2f(p[r]); s += p[r]; }
    return s;
}
__device__ __forceinline__ void sm_update1(f32x16& p, float& mhat, float& lsum, f32x16& o0, f32x16& o1, bool first) {
    float rm = max16(p); rm = fmaxf(rm, __shfl_xor(rm, 32));
    const bool mv = first || __any(rm > SM_THR);
    if (mv) { const float dl = first ? fmaxf(rm, -64.f) : fmaxf(rm, 0.f); mhat += dl; const float f = __builtin_amdgcn_exp2f(-dl); lsum *= f;
#pragma unroll
        for (int r = 0; r < 16; ++r) { p[r] -= dl; o0[r] *= f; o1[r] *= f; } }
    lsum += exp2_sum16(p);
}
__device__ __forceinline__ void sm_update2(f32x16& pa, f32x16& pb, float& mhat, float& lsum, f32x16& o0, f32x16& o1, bool first) {
    float rm = fmaxf(max16(pa), max16(pb)); rm = fmaxf(rm, __shfl_xor(rm, 32));
    const bool mv = first || __any(rm > SM_THR);
    if (mv) { const float dl = first ? fmaxf(rm, -64.f) : fmaxf(rm, 0.f); mhat += dl; const float f = __builtin_amdgcn_exp2f(-dl); lsum *= f;
#pragma unroll
        for (int r = 0; r < 16; ++r) { pa[r] -= dl; pb[r] -= dl; o0[r] *= f; o1[r] *= f; } }
    lsum += exp2_sum16(pa) + exp2_sum16(pb);
}
__device__ __forceinline__ f32x16 splat16(float v) { f32x16 r;
#pragma unroll
    for (int i = 0; i < 16; ++i) r[i] = v;
    return r; }

__device__ __forceinline__ void diff_unit(Ctx& c, int unit, float lam, float lam_init, const float* sg) {
    const int tid = c.tid, lane = tid & 63, w = __builtin_amdgcn_readfirstlane(tid >> 6), q = lane & 31, hi = lane >> 5;
    const int b = unit >> 6, hh = (unit >> 4) & 3, qb = unit & 15;
    const bf16_t* zb = c_zmix + (size_t)b * SEQ * ZC;
    const size_t trow = (size_t)(qb * 256 + w * 32 + q);
    bf16x8 qf[4];
    { const bf16_t* qrow = zb + trow * ZC + C_DFQ + hh * 64;
#pragma unroll
      for (int d0 = 0; d0 < 4; ++d0) qf[d0] = *(const bf16x8*)(qrow + 16 * d0 + 8 * hi); }
    const bf16_t* ksrc = zb + C_DFK + hh * 64 + (size_t)lane * ZC + w * 8;
    const bf16_t* vsrc = zb + C_DFV + hh * 64 + (size_t)(16 * (w & 3) + (lane >> 2)) * ZC + (w >> 2) * 32 + (lane & 3) * 8;
    LAS char* L = (LAS char*)c.ldsp;
    const int sdst = w * 1024 + lane * 16;
    const LAS char* kbase = L + hi * 1024 + q * 16;
    const int vl = vlane_off(lane);
    float mh0 = 0.f, mh1 = 0.f, l0 = 0.f, l1 = 0.f;
    f32x16 o00 = splat16(0.f), o01 = splat16(0.f), o10 = splat16(0.f), o11 = splat16(0.f);
    __syncthreads();
    { const u32x4 kr = *(const u32x4*)ksrc, vr = *(const u32x4*)vsrc; *(LAS u32x4*)(L + sdst) = kr; *(LAS u32x4*)(L + 16384 + sdst) = vr; }
    __syncthreads();
    for (int t = 0; t < SEQ / 64; ++t) {
        const int cur = (t & 1) * 8192, nxt = 8192 - cur;
        u32x4 kr, vr;
        if (t + 1 < SEQ / 64) { kr = *(const u32x4*)(ksrc + (size_t)(t + 1) * 64 * ZC); vr = *(const u32x4*)(vsrc + (size_t)(t + 1) * 64 * ZC); }
        const LAS char* kb = kbase + cur;
        bf16x8 pf0[4], pf1[4];
        {
            f32x16 sa = splat16(-mh0), sb = sa;
            sa = MFMA32(*(const LAS bf16x8*)(kb + 0 * 2048), qf[0], sa); sb = MFMA32(*(const LAS bf16x8*)(kb + 0 * 2048 + 512), qf[0], sb);
            sa = MFMA32(*(const LAS bf16x8*)(kb + 1 * 2048), qf[1], sa); sb = MFMA32(*(const LAS bf16x8*)(kb + 1 * 2048 + 512), qf[1], sb);
            sm_update2(sa, sb, mh0, l0, o00, o01, t == 0);
            pf0[0] = pack8(sa, 0); pf0[1] = pack8(sa, 1); pf0[2] = pack8(sb, 0); pf0[3] = pack8(sb, 1);
        }
        {
            f32x16 sa = splat16(-mh1), sb = sa;
            sa = MFMA32(*(const LAS bf16x8*)(kb + 2 * 2048), qf[2], sa); sb = MFMA32(*(const LAS bf16x8*)(kb + 2 * 2048 + 512), qf[2], sb);
            sa = MFMA32(*(const LAS bf16x8*)(kb + 3 * 2048), qf[3], sa); sb = MFMA32(*(const LAS bf16x8*)(kb + 3 * 2048 + 512), qf[3], sb);
            sm_update2(sa, sb, mh1, l1, o10, o11, t == 0);
            pf1[0] = pack8(sa, 0); pf1[1] = pack8(sa, 1); pf1[2] = pack8(sb, 0); pf1[3] = pack8(sb, 1);
        }
        const LAS char* vb = L + 16384 + cur + vl;
#pragma unroll
        for (int kb16 = 0; kb16 < 4; ++kb16) {
            const bf16x8 v0 = vfrag(vb + kb16 * 1024), v1 = vfrag(vb + 4096 + kb16 * 1024);
            o00 = MFMA32(v0, pf0[kb16], o00); o01 = MFMA32(v1, pf0[kb16], o01);
            o10 = MFMA32(v0, pf1[kb16], o10); o11 = MFMA32(v1, pf1[kb16], o11);
        }
        if (t + 1 < SEQ / 64) { *(LAS u32x4*)(L + nxt + sdst) = kr; *(LAS u32x4*)(L + 16384 + nxt + sdst) = vr; }
        __syncthreads();
    }
    l0 += __shfl_xor(l0, 32); l1 += __shfl_xor(l1, 32);
    const float i0 = 1.f / l0, i1 = lam / l1;
    float ss = 0.f;
#pragma unroll
    for (int r = 0; r < 16; ++r) { o00[r] = o00[r] * i0 - o10[r] * i1; o01[r] = o01[r] * i0 - o11[r] * i1; ss += o00[r] * o00[r] + o01[r] * o01[r]; }
    ss += __shfl_xor(ss, 32);
    const float rr = (1.f - lam_init) / sqrtf(ss * (1.f / 64.f) + LN_EPS);
    bf16_t* yp = c_ys + ((size_t)b * SEQ + trow) * DM + 256 + hh * 64;
#pragma unroll
    for (int g = 0; g < 4; ++g) { const int d = 8 * g + 4 * hi;
        const f32x4 s0 = *(const f32x4*)(sg + d), s1 = *(const f32x4*)(sg + 32 + d);
        u32x2 wv; wv.x = pg8::cvt_pk_bf16(o00[4 * g] * rr * s0.x, o00[4 * g + 1] * rr * s0.y); wv.y = pg8::cvt_pk_bf16(o00[4 * g + 2] * rr * s0.z, o00[4 * g + 3] * rr * s0.w);
        *(u32x2*)(yp + d) = wv;
        wv.x = pg8::cvt_pk_bf16(o01[4 * g] * rr * s1.x, o01[4 * g + 1] * rr * s1.y); wv.y = pg8::cvt_pk_bf16(o01[4 * g + 2] * rr * s1.z, o01[4 * g + 3] * rr * s1.w);
        *(u32x2*)(yp + 32 + d) = wv; }
}
__device__ __forceinline__ void st_diff_fast(Ctx& c, int l) {
    const float* dl = c.a->in[6] + (size_t)l * 4 * 32;
    const float* sg = c.a->in[7] + (size_t)l * 64;
    const float lam_init = 0.8f - 0.6f * expf(-0.3f * (float)l);
    float s01 = 0.f, s23 = 0.f;
    for (int i = 0; i < 32; ++i) { s01 += dl[i] * dl[32 + i]; s23 += dl[64 + i] * dl[96 + i]; }
    const float lam = expf(s01) - expf(s23) + lam_init;
    for (int u = c.bid; u < 256; u += c.nblk) diff_unit(c, u, lam, lam_init, sg);
}

template <class RowF>
__device__ __forceinline__ void stage_v32(LAS char* img, int lane, RowF vrow) {
    u32x4 r[4];
#pragma unroll
    for (int i = 0; i < 4; ++i) { const int ci = i * 64 + lane, key = ci >> 3, ch = ci & 7; r[i] = *(const u32x4*)(vrow(key) + ch * 8); }
#pragma unroll
    for (int i = 0; i < 4; ++i) { const int ci = i * 64 + lane, key = ci >> 3, ch = ci & 7; *(LAS u32x4*)(img + (ch >> 2) * 2048 + key * 64 + (ch & 3) * 16) = r[i]; }
}
__device__ __forceinline__ void pv32(const LAS char* img, int vl, const f32x16& p, f32x16& o0, f32x16& o1) {
    const bf16x8 p0 = pack8(p, 0), p1 = pack8(p, 1);
    const bf16x8 v00 = vfrag(img + vl), v01 = vfrag(img + 2048 + vl), v10 = vfrag(img + 1024 + vl), v11 = vfrag(img + 2048 + 1024 + vl);
    o0 = MFMA32(v00, p0, o0); o1 = MFMA32(v01, p0, o1); o0 = MFMA32(v10, p1, o0); o1 = MFMA32(v11, p1, o1);
}
__device__ __forceinline__ void store_o64(bf16_t* yp, int hi, const f32x16& o0, const f32x16& o1, float inv) {
#pragma unroll
    for (int g = 0; g < 4; ++g) { const int d = 8 * g + 4 * hi; u32x2 wv;
        wv.x = pg8::cvt_pk_bf16(o0[4 * g] * inv, o0[4 * g + 1] * inv); wv.y = pg8::cvt_pk_bf16(o0[4 * g + 2] * inv, o0[4 * g + 3] * inv); *(u32x2*)(yp + d) = wv;
        wv.x = pg8::cvt_pk_bf16(o1[4 * g] * inv, o1[4 * g + 1] * inv); wv.y = pg8::cvt_pk_bf16(o1[4 * g + 2] * inv, o1[4 * g + 3] * inv); *(u32x2*)(yp + 32 + d) = wv; }
}
__device__ __forceinline__ void st_na_fast(Ctx& c, int l) {
    const int tid = c.tid, lane = tid & 63, w = __builtin_amdgcn_readfirstlane(tid >> 6), q = lane & 31, hi = lane >> 5;
    LAS char* img = (LAS char*)c.ldsp + w * 4096; const int vl = vlane_off(lane);
    const float* rp = c_rpbt + (size_t)l * 4 * 15 * 31;
    for (int task = c.bid * 8 + w; task < NB * 4 * 64 * 2; task += c.nblk * 8) {
        const int qh = task & 1, r = (task >> 1) & 63, hh = (task >> 7) & 3, b = task >> 9;
        const int cq = 32 * qh + q, rs = min(max(r - 4, 0), 56), cs = min(max(cq - 8, 0), 48);
        const bf16_t* zb = c_zmix + (size_t)b * SEQ * ZC;
        const size_t tq = (size_t)(r * 64 + cq);
        bf16x8 qf[4];
        { const bf16_t* qrow = zb + tq * ZC + C_NAQ + hh * 64;
#pragma unroll
          for (int d0 = 0; d0 < 4; ++d0) qf[d0] = *(const bf16x8*)(qrow + 16 * d0 + 8 * hi); }
        float mh = 0.f, ls = 0.f; f32x16 o0 = splat16(0.f), o1 = splat16(0.f);
        for (int it = 0; it < 16; ++it) {
            const int kk = it >> 1, ch = (it & 1) ^ qh, kr = rs + kk, dr = kr - r + 7;
            const bf16_t* kt = zb + (size_t)(kr * 64 + 32 * ch) * ZC + hh * 64;
            stage_v32(img, lane, [&](int key) { return kt + (size_t)key * ZC + C_NAV; });
            f32x16 p;
#pragma unroll
            for (int rg = 0; rg < 16; ++rg) { const int ck = 32 * ch + crow(rg, hi); const bool ok = (ck >= cs) && (ck < cs + 16);
                const int dc = min(max(ck - cq + 15, 0), 30);
                p[rg] = (ok ? rp[(hh * 15 + dr) * 31 + dc] : MASKV) - mh; }
            const bf16_t* krow = kt + (size_t)q * ZC + C_NAK + 8 * hi;
#pragma unroll
            for (int d0 = 0; d0 < 4; ++d0) p = MFMA32(*(const bf16x8*)(krow + 16 * d0), qf[d0], p);
            sm_update1(p, mh, ls, o0, o1, it == 0);
            pv32(img, vl, p, o0, o1);
        }
        ls += __shfl_xor(ls, 32);
        store_o64(c_ys + ((size_t)b * SEQ + tq) * DM + hh * 64, hi, o0, o1, 1.f / ls);
    }
}
__device__ __forceinline__ void st_dil_fast(Ctx& c) {
    const int tid = c.tid, lane = tid & 63, w = __builtin_amdgcn_readfirstlane(tid >> 6), q = lane & 31, hi = lane >> 5;
    LAS char* img = (LAS char*)c.ldsp + w * 4096; const int vl = vlane_off(lane);
    for (int task = c.bid * 8 + w; task < NB * 4 * 8 * 16; task += c.nblk * 8) {
        const int m16 = task & 15, blk = (task >> 4) & 7, hh = (task >> 7) & 3, b = task >> 9;
        const int s0 = blk * 512 + m16, sq = s0 + 16 * q;
        const bf16_t* zb = c_zmix + (size_t)b * SEQ * ZC;
        float mh = 0.f, ls = 0.f; f32x16 o0 = splat16(0.f), o1 = splat16(0.f);
        bool first = true;
        for (int p3 = 0; p3 < 3; ++p3) {
            const int sh = 2 * p3, rr = 1 << sh, Lp = SEQ >> sh, li0 = s0 >> sh, res = s0 & (rr - 1), st = 16 >> sh, li = li0 + q * st;
            const int ntile = (31 * st + 129 + 31) >> 5;
            const bf16_t* zp = zb + C_DL + p3 * 768 + hh * 64;
            bf16x8 qf[4];
            { const bf16_t* qrow = zp + (size_t)sq * ZC;
#pragma unroll
              for (int d0 = 0; d0 < 4; ++d0) qf[d0] = *(const bf16x8*)(qrow + 16 * d0 + 8 * hi); }
            for (int tt = 0; tt < ntile; ++tt) {
                const int lj0 = li0 - 64 + 32 * tt;
                auto keypos = [&](int key) { const int lj = min(max(lj0 + key, 0), Lp - 1); return (size_t)((lj << sh) + res); };
                stage_v32(img, lane, [&](int key) { return zp + keypos(key) * ZC + 512; });
                f32x16 p;
#pragma unroll
                for (int rg = 0; rg < 16; ++rg) { const int lj = lj0 + crow(rg, hi); const int df = lj - li; const bool ok = (lj >= 0) && (lj < Lp) && (df <= 64) && (df >= -64);
                    p[rg] = (ok ? 0.f : MASKV) - mh; }
                const bf16_t* krow = zp + keypos(q) * ZC + 256 + 8 * hi;
#pragma unroll
                for (int d0 = 0; d0 < 4; ++d0) p = MFMA32(*(const bf16x8*)(krow + 16 * d0), qf[d0], p);
                sm_update1(p, mh, ls, o0, o1, first); first = false;
                pv32(img, vl, p, o0, o1);
            }
        }
        ls += __shfl_xor(ls, 32);
        store_o64(c_ys + ((size_t)b * SEQ + sq) * DM + 768 + hh * 64, hi, o0, o1, 1.f / ls);
    }
}
__device__ __forceinline__ void st_pool_fast(Ctx& c, int l) {
    const int tid = c.tid, lane = tid & 63, w = __builtin_amdgcn_readfirstlane(tid >> 6), q = lane & 31, hi = lane >> 5;
    const bf16_t* pwt = c_pwt + (size_t)l * 4 * 64 * 64; const float* ps = c.a->in[9] + (size_t)l * 256;
    for (int task = c.bid * 8 + w; task < MT / 32; task += c.nblk * 8) {
        const int t = task * 32 + q, s = t & (SEQ - 1), b0 = t - s;
#pragma unroll
        for (int g = 0; g < 4; ++g) {
            const int wd = 2 << g, lo = max(s - wd / 2, 0), hi_ = min(s + wd - 1 - wd / 2, SEQ - 1);
            const float inv = 1.f / (float)(hi_ - lo + 1);
            bf16x8 df[4];
#pragma unroll
            for (int d0 = 0; d0 < 4; ++d0) {
                const bf16_t* up = c_zmix + C_PL + g * 64 + 16 * d0 + 8 * hi;
                float sum[8];
#pragma unroll
                for (int j = 0; j < 8; ++j) sum[j] = 0.f;
                for (int p = lo; p <= hi_; ++p) { const u32x4 v = *(const u32x4*)(up + (size_t)(b0 + p) * ZC);
                    sum[0] += lo16(v.x); sum[1] += hi16(v.x); sum[2] += lo16(v.y); sum[3] += hi16(v.y); sum[4] += lo16(v.z); sum[5] += hi16(v.z); sum[6] += lo16(v.w); sum[7] += hi16(v.w); }
                const u32x4 v = *(const u32x4*)(up + (size_t)t * ZC);
                u32x4 wv; wv.x = pg8::cvt_pk_bf16(sum[0] * inv - lo16(v.x), sum[1] * inv - hi16(v.x)); wv.y = pg8::cvt_pk_bf16(sum[2] * inv - lo16(v.y), sum[3] * inv - hi16(v.y));
                wv.z = pg8::cvt_pk_bf16(sum[4] * inv - lo16(v.z), sum[5] * inv - hi16(v.z)); wv.w = pg8::cvt_pk_bf16(sum[6] * inv - lo16(v.w), sum[7] * inv - hi16(v.w));
                df[d0] = __builtin_bit_cast(bf16x8, wv);
            }
#pragma unroll
            for (int eh = 0; eh < 2; ++eh) {
                f32x16 acc = splat16(0.f);
                const bf16_t* wp = pwt + ((size_t)g * 64 + 32 * eh + q) * 64 + 8 * hi;
#pragma unroll
                for (int d0 = 0; d0 < 4; ++d0) acc = MFMA32(*(const bf16x8*)(wp + 16 * d0), df[d0], acc);
                bf16_t* yp = c_ys + (size_t)t * DM + 512 + g * 64 + 32 * eh;
#pragma unroll
                for (int gg = 0; gg < 4; ++gg) { const int e = 8 * gg + 4 * hi; const f32x4 sc = *(const f32x4*)(ps + g * 64 + 32 * eh + e);
                    u32x2 wv; wv.x = pg8::cvt_pk_bf16(acc[4 * gg] * sc.x, acc[4 * gg + 1] * sc.y); wv.y = pg8::cvt_pk_bf16(acc[4 * gg + 2] * sc.z, acc[4 * gg + 3] * sc.w);
                    *(u32x2*)(yp + e) = wv; }
            }
        }
    }
}

__device__ __forceinline__ void st_rope(Ctx& c) {
    for (long i = c.gtid(); i < (long)MT * 256; i += c.ngt()) {
        const int t = (int)(i >> 8), j = (int)(i & 255), pos = t & (SEQ - 1);
        int col1, col2; float cs, sn;
        if (j < 64) { const int qk = j >> 5, hh = (j >> 3) & 3, m = (j >> 2) & 1, ii = j & 3;
            col1 = C_DFQ + qk * 256 + hh * 64 + m * 32 + ii; col2 = col1 + 4; cs = c_rc8[pos * 4 + ii]; sn = c_rs8[pos * 4 + ii]; }
        else { const int jj = j - 64, p = jj >> 6, r = jj & 63, qk = r >> 5, hh = (r >> 3) & 3, ii = r & 7;
            col1 = C_DL + p * 768 + qk * 256 + hh * 64 + ii; col2 = col1 + 8; cs = c_rc16[pos * 8 + ii]; sn = c_rs16[pos * 8 + ii]; }
        bf16_t* zr = c_zmix + (size_t)t * ZC;
        const float x1 = bf2f(zr[col1]), x2 = bf2f(zr[col2]);
        zr[col1] = (bf16_t)f2bf(x1 * cs - x2 * sn); zr[col2] = (bf16_t)f2bf(x1 * sn + x2 * cs);
    }
}

#define LOAD8(dst, p) const u32x4 dst = *(const u32x4*)(p)

__device__ __forceinline__ void st_na(Ctx& c, int l) {
    const float* rpb = c.a->in[5] + (size_t)l * 4 * 15 * 31;
    for (long i = c.gtid(); i < (long)MT * 4; i += c.ngt()) {
        const int s = (int)(i & (SEQ - 1)), hh = (int)((i >> 12) & 3), b = (int)(i >> 14);
        const int r = s >> 6, cq = s & 63;
        const int rs = min(max(r - 4, 0), 56), cs = min(max(cq - 8, 0), 48);
        const size_t t = (size_t)b * SEQ + s;
        float q[64], o[64];
        {
            const bf16_t* qp = c_zmix + t * ZC + C_NAQ + hh * 64;
#pragma unroll
            for (int d8 = 0; d8 < 8; ++d8) { LOAD8(w, qp + d8 * 8);
                q[d8 * 8 + 0] = lo16(w.x) * 0.125f; q[d8 * 8 + 1] = hi16(w.x) * 0.125f; q[d8 * 8 + 2] = lo16(w.y) * 0.125f; q[d8 * 8 + 3] = hi16(w.y) * 0.125f;
                q[d8 * 8 + 4] = lo16(w.z) * 0.125f; q[d8 * 8 + 5] = hi16(w.z) * 0.125f; q[d8 * 8 + 6] = lo16(w.w) * 0.125f; q[d8 * 8 + 7] = hi16(w.w) * 0.125f; }
        }
#pragma unroll
        for (int d = 0; d < 64; ++d) o[d] = 0.f;
        float mx = -INFINITY, ls = 0.f;
        for (int kk = 0; kk < 8; ++kk) {
            const int kr = rs + kk, dr = kr - r + 7;
            for (int cc = 0; cc < 16; ++cc) {
                const int ck = cs + cc, dc = ck - cq + 15;
                const size_t tk = (size_t)b * SEQ + kr * 64 + ck;
                const bf16_t* kp = c_zmix + tk * ZC + C_NAK + hh * 64;
                const bf16_t* vp = c_zmix + tk * ZC + C_NAV + hh * 64;
                float sc = rpb[(hh * 15 + dr) * 31 + dc];
#pragma unroll
                for (int d8 = 0; d8 < 8; ++d8) { LOAD8(w, kp + d8 * 8);
                    sc += q[d8 * 8 + 0] * lo16(w.x) + q[d8 * 8 + 1] * hi16(w.x) + q[d8 * 8 + 2] * lo16(w.y) + q[d8 * 8 + 3] * hi16(w.y)
                        + q[d8 * 8 + 4] * lo16(w.z) + q[d8 * 8 + 5] * hi16(w.z) + q[d8 * 8 + 6] * lo16(w.w) + q[d8 * 8 + 7] * hi16(w.w); }
                const float mn = fmaxf(mx, sc), al = __expf(mx - mn), p = __expf(sc - mn);
                ls = ls * al + p; mx = mn;
#pragma unroll
                for (int d8 = 0; d8 < 8; ++d8) { LOAD8(w, vp + d8 * 8);
                    o[d8 * 8 + 0] = o[d8 * 8 + 0] * al + p * lo16(w.x); o[d8 * 8 + 1] = o[d8 * 8 + 1] * al + p * hi16(w.x);
                    o[d8 * 8 + 2] = o[d8 * 8 + 2] * al + p * lo16(w.y); o[d8 * 8 + 3] = o[d8 * 8 + 3] * al + p * hi16(w.y);
                    o[d8 * 8 + 4] = o[d8 * 8 + 4] * al + p * lo16(w.z); o[d8 * 8 + 5] = o[d8 * 8 + 5] * al + p * hi16(w.z);
                    o[d8 * 8 + 6] = o[d8 * 8 + 6] * al + p * lo16(w.w); o[d8 * 8 + 7] = o[d8 * 8 + 7] * al + p * hi16(w.w); }
            }
        }
        const float inv = 1.f / ls;
        bf16_t* yp = c_ys + t * DM + 0 + hh * 64;
#pragma unroll
        for (int d8 = 0; d8 < 8; ++d8) { u32x4 w; w.x = pk2(o[d8 * 8 + 0] * inv, o[d8 * 8 + 1] * inv); w.y = pk2(o[d8 * 8 + 2] * inv, o[d8 * 8 + 3] * inv);
            w.z = pk2(o[d8 * 8 + 4] * inv, o[d8 * 8 + 5] * inv); w.w = pk2(o[d8 * 8 + 6] * inv, o[d8 * 8 + 7] * inv); *(u32x4*)(yp + d8 * 8) = w; }
    }
}

__device__ __forceinline__ void st_diff(Ctx& c, int l) {
    const float* dl = c.a->in[6] + (size_t)l * 4 * 32;
    const float* sg = c.a->in[7] + (size_t)l * 64;
    const float lam_init = 0.8f - 0.6f * expf(-0.3f * (float)l);
    float s01 = 0.f, s23 = 0.f;
    for (int i = 0; i < 32; ++i) { s01 += dl[i] * dl[32 + i]; s23 += dl[64 + i] * dl[96 + i]; }
    const float lam = expf(s01) - expf(s23) + lam_init;
    for (long i = c.gtid(); i < (long)MT * 8; i += c.ngt()) {
        const int m = (int)(i & 1), s = (int)((i >> 1) & (SEQ - 1)), hh = (int)((i >> 13) & 3), b = (int)(i >> 15);
        const size_t t = (size_t)b * SEQ + s;
        float q[32], o[64];
        { const bf16_t* qp = c_zmix + t * ZC + C_DFQ + hh * 64 + m * 32;
#pragma unroll
          for (int d8 = 0; d8 < 4; ++d8) { LOAD8(w, qp + d8 * 8); const float sc = 0.17677669529663687f;
              q[d8 * 8 + 0] = lo16(w.x) * sc; q[d8 * 8 + 1] = hi16(w.x) * sc; q[d8 * 8 + 2] = lo16(w.y) * sc; q[d8 * 8 + 3] = hi16(w.y) * sc;
              q[d8 * 8 + 4] = lo16(w.z) * sc; q[d8 * 8 + 5] = hi16(w.z) * sc; q[d8 * 8 + 6] = lo16(w.w) * sc; q[d8 * 8 + 7] = hi16(w.w) * sc; } }
#pragma unroll
        for (int d = 0; d < 64; ++d) o[d] = 0.f;
        float mx = -INFINITY, ls = 0.f;
        const bf16_t* kbase = c_zmix + (size_t)b * SEQ * ZC + C_DFK + hh * 64 + m * 32;
        const bf16_t* vbase = c_zmix + (size_t)b * SEQ * ZC + C_DFV + hh * 64;
        for (int j = 0; j < SEQ; ++j) {
            const bf16_t* kp = kbase + (size_t)j * ZC; const bf16_t* vp = vbase + (size_t)j * ZC;
            float sc = 0.f;
#pragma unroll
            for (int d8 = 0; d8 < 4; ++d8) { LOAD8(w, kp + d8 * 8);
                sc += q[d8 * 8 + 0] * lo16(w.x) + q[d8 * 8 + 1] * hi16(w.x) + q[d8 * 8 + 2] * lo16(w.y) + q[d8 * 8 + 3] * hi16(w.y)
                    + q[d8 * 8 + 4] * lo16(w.z) + q[d8 * 8 + 5] * hi16(w.z) + q[d8 * 8 + 6] * lo16(w.w) + q[d8 * 8 + 7] * hi16(w.w); }
            const float mn = fmaxf(mx, sc), al = __expf(mx - mn), p = __expf(sc - mn);
            ls = ls * al + p; mx = mn;
#pragma unroll
            for (int d8 = 0; d8 < 8; ++d8) { LOAD8(w, vp + d8 * 8);
                o[d8 * 8 + 0] = o[d8 * 8 + 0] * al + p * lo16(w.x); o[d8 * 8 + 1] = o[d8 * 8 + 1] * al + p * hi16(w.x);
                o[d8 * 8 + 2] = o[d8 * 8 + 2] * al + p * lo16(w.y); o[d8 * 8 + 3] = o[d8 * 8 + 3] * al + p * hi16(w.y);
                o[d8 * 8 + 4] = o[d8 * 8 + 4] * al + p * lo16(w.z); o[d8 * 8 + 5] = o[d8 * 8 + 5] * al + p * hi16(w.z);
                o[d8 * 8 + 6] = o[d8 * 8 + 6] * al + p * lo16(w.w); o[d8 * 8 + 7] = o[d8 * 8 + 7] * al + p * hi16(w.w); }
        }
        const float inv = 1.f / ls;
        float ss = 0.f;
#pragma unroll
        for (int d = 0; d < 64; ++d) { const float mine = o[d] * inv; const float oth = __shfl_xor(mine, 1); const float a = mine - lam * oth; o[d] = a; ss += a * a; }
        if (m == 0) {
            const float rr = 1.f / sqrtf(ss * (1.f / 64.f) + LN_EPS) * (1.f - lam_init);
            bf16_t* yp = c_ys + t * DM + 256 + hh * 64;
#pragma unroll
            for (int d8 = 0; d8 < 8; ++d8) { u32x4 w;
                w.x = pk2(o[d8 * 8 + 0] * rr * sg[d8 * 8 + 0], o[d8 * 8 + 1] * rr * sg[d8 * 8 + 1]); w.y = pk2(o[d8 * 8 + 2] * rr * sg[d8 * 8 + 2], o[d8 * 8 + 3] * rr * sg[d8 * 8 + 3]);
                w.z = pk2(o[d8 * 8 + 4] * rr * sg[d8 * 8 + 4], o[d8 * 8 + 5] * rr * sg[d8 * 8 + 5]); w.w = pk2(o[d8 * 8 + 6] * rr * sg[d8 * 8 + 6], o[d8 * 8 + 7] * rr * sg[d8 * 8 + 7]);
                *(u32x4*)(yp + d8 * 8) = w; }
        }
    }
}

__device__ __forceinline__ void st_pool(Ctx& c, int l) {
    const float* pw = c.a->in[8] + (size_t)l * 4 * 64 * 64;
    const float* ps = c.a->in[9] + (size_t)l * 256;
    for (long i = c.gtid(); i < (long)MT * 256; i += c.ngt()) {
        const int t = (int)(i >> 8), cc = (int)(i & 255), g = cc >> 6, e = cc & 63, w = 2 << g;
        const int s = t & (SEQ - 1), b0 = t - s;
        const int lo = max(s - w / 2, 0), hi = min(s + w - 1 - w / 2, SEQ - 1);
        const float inv = 1.f / (float)(hi - lo + 1);
        float acc = 0.f;
        for (int k = 0; k < 64; ++k) {
            float sum = 0.f;
            for (int p = lo; p <= hi; ++p) sum += bf2f(c_zmix[(size_t)(b0 + p) * ZC + C_PL + g * 64 + k]);
            const float dlt = sum * inv - bf2f(c_zmix[(size_t)t * ZC + C_PL + g * 64 + k]);
            acc += dlt * pw[(g * 64 + k) * 64 + e];
        }
        c_ys[(size_t)t * DM + 512 + cc] = (bf16_t)f2bf(acc * ps[cc]);
    }
}

__device__ __forceinline__ void st_dil(Ctx& c) {
    for (long i = c.gtid(); i < (long)MT * 4; i += c.ngt()) {
        const int s = (int)(i & (SEQ - 1)), hh = (int)((i >> 12) & 3), b = (int)(i >> 14);
        const size_t t = (size_t)b * SEQ + s;
        float q[64], o[64];
#pragma unroll
        for (int d = 0; d < 64; ++d) o[d] = 0.f;
        float mx = -INFINITY, ls = 0.f;
        for (int p = 0; p < 3; ++p) {
            const int sh = 2 * p, r = 1 << sh, L = SEQ >> sh, li = s >> sh, res = s & (r - 1);
            { const bf16_t* qp = c_zmix + t * ZC + C_DL + p * 768 + hh * 64;
#pragma unroll
              for (int d8 = 0; d8 < 8; ++d8) { LOAD8(w, qp + d8 * 8);
                  q[d8 * 8 + 0] = lo16(w.x) * 0.125f; q[d8 * 8 + 1] = hi16(w.x) * 0.125f; q[d8 * 8 + 2] = lo16(w.y) * 0.125f; q[d8 * 8 + 3] = hi16(w.y) * 0.125f;
                  q[d8 * 8 + 4] = lo16(w.z) * 0.125f; q[d8 * 8 + 5] = hi16(w.z) * 0.125f; q[d8 * 8 + 6] = lo16(w.w) * 0.125f; q[d8 * 8 + 7] = hi16(w.w) * 0.125f; } }
            for (int j = -64; j <= 64; ++j) {
                const int lj = li + j;
                if (lj < 0 || lj >= L) continue;
                const size_t tk = (size_t)b * SEQ + ((size_t)lj << sh) + res;
                const bf16_t* kp = c_zmix + tk * ZC + C_DL + p * 768 + 256 + hh * 64;
                const bf16_t* vp = c_zmix + tk * ZC + C_DL + p * 768 + 512 + hh * 64;
                float sc = 0.f;
#pragma unroll
                for (int d8 = 0; d8 < 8; ++d8) { LOAD8(w, kp + d8 * 8);
                    sc += q[d8 * 8 + 0] * lo16(w.x) + q[d8 * 8 + 1] * hi16(w.x) + q[d8 * 8 + 2] * lo16(w.y) + q[d8 * 8 + 3] * hi16(w.y)
                        + q[d8 * 8 + 4] * lo16(w.z) + q[d8 * 8 + 5] * hi16(w.z) + q[d8 * 8 + 6] * lo16(w.w) + q[d8 * 8 + 7] * hi16(w.w); }
                const float mn = fmaxf(mx, sc), al = __expf(mx - mn), pp = __expf(sc - mn);
                ls = ls * al + pp; mx = mn;
#pragma unroll
                for (int d8 = 0; d8 < 8; ++d8) { LOAD8(w, vp + d8 * 8);
                    o[d8 * 8 + 0] = o[d8 * 8 + 0] * al + pp * lo16(w.x); o[d8 * 8 + 1] = o[d8 * 8 + 1] * al + pp * hi16(w.x);
                    o[d8 * 8 + 2] = o[d8 * 8 + 2] * al + pp * lo16(w.y); o[d8 * 8 + 3] = o[d8 * 8 + 3] * al + pp * hi16(w.y);
                    o[d8 * 8 + 4] = o[d8 * 8 + 4] * al + pp * lo16(w.z); o[d8 * 8 + 5] = o[d8 * 8 + 5] * al + pp * hi16(w.z);
                    o[d8 * 8 + 6] = o[d8 * 8 + 6] * al + pp * lo16(w.w); o[d8 * 8 + 7] = o[d8 * 8 + 7] * al + pp * hi16(w.w); }
            }
        }
        const float inv = 1.f / ls;
        bf16_t* yp = c_ys + t * DM + 768 + hh * 64;
#pragma unroll
        for (int d8 = 0; d8 < 8; ++d8) { u32x4 w; w.x = pk2(o[d8 * 8 + 0] * inv, o[d8 * 8 + 1] * inv); w.y = pk2(o[d8 * 8 + 2] * inv, o[d8 * 8 + 3] * inv);
            w.z = pk2(o[d8 * 8 + 4] * inv, o[d8 * 8 + 5] * inv); w.w = pk2(o[d8 * 8 + 6] * inv, o[d8 * 8 + 7] * inv); *(u32x4*)(yp + d8 * 8) = w; }
    }
}

__device__ __forceinline__ void st_merge(Ctx& c, int l) {
    const float* wb = c.a->in[10] + (size_t)l * 4 * 256 * DM;
    for (long i = c.gtid(); i < (long)MT * DM; i += c.ngt()) {
        const int t = (int)(i >> 10), d = (int)(i & 1023);
        float tot = 0.f;
        for (int n = 0; n < 4; ++n) {
            const bf16_t* yp = c_ys + (size_t)t * DM + n * 256;
            const float* wp = wb + (size_t)n * 256 * DM + d;
            float a = 0.f;
            for (int c8 = 0; c8 < 32; ++c8) { LOAD8(w, yp + c8 * 8); const float* w8 = wp + (size_t)c8 * 8 * DM;
                a += lo16(w.x) * w8[0] + hi16(w.x) * w8[DM] + lo16(w.y) * w8[2 * DM] + hi16(w.y) * w8[3 * DM]
                   + lo16(w.z) * w8[4 * DM] + hi16(w.z) * w8[5 * DM] + lo16(w.w) * w8[6 * DM] + hi16(w.w) * w8[7 * DM]; }
            tot += bf2f(c_gates[(size_t)t * GC + n * DM + d]) * a;
        }
        c_merged[(size_t)t * DM + d] = (bf16_t)f2bf(tot);
    }
}

__device__ __forceinline__ void st_outgemm(Ctx& c, int l) {
    const float* W = c.a->in[11] + (size_t)l * DM * DM;
    for (long i = c.gtid(); i < CAP; i += c.ngt()) c_tok[i] = -1;
    for (int t = c.bid; t < (MT / 64) * (DM / 128); t += c.nblk) {
        const int tn = t % (DM / 128), tm = t / (DM / 128), m0 = tm * 64, n0 = tn * 128;
        const bf16_t* mg = c_merged; const float* h = c.h; float* ypre = c_ypre;
        ngemm_tile(c.sm(), c.tid, DM,
            [&](int r, int k) { return bf2f(mg[(size_t)(m0 + r) * DM + k]); },
            [&](int k, int c4) { return *(const f32x4*)(W + (size_t)k * DM + n0 + c4); },
            [&](int r, int c4, f32x4 v) { const size_t off = (size_t)(m0 + r) * DM + n0 + c4;
                const f32x4 hv = *(const f32x4*)(h + off); *(f32x4*)(ypre + off) = ALPHA * hv + v; });
    }
}

__device__ __forceinline__ void st_ln1_router(Ctx& c, int l) {
    const float* g1 = c.a->in[12] + (size_t)l * DM; const float* b1 = c.a->in[13] + (size_t)l * DM;
    const float* rgw = c.a->in[14] + (size_t)l * DM * 4; const float* rgb = c.a->in[15] + (size_t)l * 4;
    const float* rew = c.a->in[16] + (size_t)l * DM * 32; const float* reb = c.a->in[17] + (size_t)l * 32;
    unsigned* cnt = c_ctl + CW_CNT + l * 32;
    for (int m = c.gw(); m < MT; m += c.ngw()) {
        f32x4 v[4];
#pragma unroll
        for (int j = 0; j < 4; ++j) v[j] = *(const f32x4*)(c_ypre + (size_t)m * DM + 4 * c.lane() + 256 * j);
        wave_ln_store(v, g1, b1, c.h + (size_t)m * DM, c_hb + (size_t)m * DM, c.lane());
        float gl[4] = {0.f, 0.f, 0.f, 0.f};
#pragma unroll
        for (int j = 0; j < 4; ++j) {
            const int k0 = 4 * c.lane() + 256 * j;
#pragma unroll
            for (int e = 0; e < 4; ++e) { const float hv = v[j][e]; const f32x4 w = *(const f32x4*)(rgw + (size_t)(k0 + e) * 4);
                gl[0] += hv * w.x; gl[1] += hv * w.y; gl[2] += hv * w.z; gl[3] += hv * w.w; }
        }
#pragma unroll
        for (int q = 0; q < 4; ++q) gl[q] = wave_sum(gl[q]) + rgb[q];
        int gs = 0; float gm = gl[0];
#pragma unroll
        for (int q = 1; q < 4; ++q) if (gl[q] > gm) { gm = gl[q]; gs = q; }
        float den = 0.f;
#pragma unroll
        for (int q = 0; q < 4; ++q) den += expf(gl[q] - gm);
        const float pg = 1.f / den;
        float el[8];
#pragma unroll
        for (int q = 0; q < 8; ++q) el[q] = 0.f;
#pragma unroll
        for (int j = 0; j < 4; ++j) {
            const int k0 = 4 * c.lane() + 256 * j;
#pragma unroll
            for (int e = 0; e < 4; ++e) { const float hv = v[j][e]; const float* wp = rew + (size_t)(k0 + e) * 32 + gs * 8;
                const f32x4 w0 = *(const f32x4*)wp, w1 = *(const f32x4*)(wp + 4);
                el[0] += hv * w0.x; el[1] += hv * w0.y; el[2] += hv * w0.z; el[3] += hv * w0.w;
                el[4] += hv * w1.x; el[5] += hv * w1.y; el[6] += hv * w1.z; el[7] += hv * w1.w; }
        }
#pragma unroll
        for (int q = 0; q < 8; ++q) el[q] = wave_sum(el[q]) + reb[gs * 8 + q];
        int i1 = 0; float v1 = el[0];
#pragma unroll
        for (int q = 1; q < 8; ++q) if (el[q] > v1) { v1 = el[q]; i1 = q; }
        int i2 = -1; float v2 = -INFINITY;
#pragma unroll
        for (int q = 0; q < 8; ++q) if (q != i1 && el[q] > v2) { v2 = el[q]; i2 = q; }
        const float e2 = expf(v2 - v1), g1w = pg / (1.f + e2), g2w = pg * e2 / (1.f + e2);
        if (c.lane() == 0) {
            const int ea = gs * 8 + i1, eb = gs * 8 + i2;
            c_eid[m * 2] = ea; c_eid[m * 2 + 1] = eb; c_gwt[m * 2] = g1w; c_gwt[m * 2 + 1] = g2w;
            atomicAdd(cnt + ea, 1u); atomicAdd(cnt + eb, 1u);
        }
    }
}

__device__ __forceinline__ void st_pack(Ctx& c, int l) {
    unsigned* cnt = c_ctl + CW_CNT + l * 32; unsigned* cur = c_ctl + CW_CUR + l * 32;
    int* offs = (int*)c.sm();
    if (c.tid == 0) { int o = 0; for (int e = 0; e < NEXP; ++e) { offs[e] = o; const int n = (int)__hip_atomic_load(cnt + e, __ATOMIC_RELAXED, __HIP_MEMORY_SCOPE_AGENT); o += (n + 255) / 256 * 256; } offs[32] = o; }
    __syncthreads();
    if (c.bid == 0) {
        for (int i = c.tid; i < NTILE; i += NTHR) { const int row = i * 256; int e = -1;
            if (row < offs[32]) { e = 0; for (int q = 1; q < NEXP; ++q) if (row >= offs[q]) e = q; }
            c_tile_e[i] = e; }
    }
    for (long i = c.gtid(); i < (long)MT * 2; i += c.ngt()) {
        const int e = c_eid[i];
        const int pos = offs[e] + (int)atomicAdd(cur + e, 1u);
        c_slot[i] = pos; c_tok[pos] = (int)(i >> 1);
    }
    __syncthreads();
}

__device__ __forceinline__ float silu(float x) { return x / (1.f + __expf(-x)); }

__device__ __forceinline__ void st_moe1(Ctx& c, int l) {
    const float* WG = c.a->in[18] + (size_t)l * NEXP * DM * DEXP;
    const float* WU = c.a->in[19] + (size_t)l * NEXP * DM * DEXP;
    for (int t = c.bid; t < (CAP / 64) * (DEXP / 64); t += c.nblk) {
        const int tn = t % (DEXP / 64), tm = t / (DEXP / 64), m0 = tm * 64, j0 = tn * 64;
        const int e = c_tile_e[m0 >> 8];
        if (e < 0) continue;
        const float* wg = WG + (size_t)e * DM * DEXP; const float* wu = WU + (size_t)e * DM * DEXP;
        const bf16_t* hb = c_hb; const int* tok = c_tok; bf16_t* hmid = c_hmid;
        ngemm_tile(c.sm(), c.tid, DM,
            [&](int r, int k) { const int tk = tok[m0 + r]; return tk < 0 ? 0.f : bf2f(hb[(size_t)tk * DM + k]); },
            [&](int k, int c4) { return c4 < 64 ? *(const f32x4*)(wg + (size_t)k * DEXP + j0 + c4) : *(const f32x4*)(wu + (size_t)k * DEXP + j0 + c4 - 64); },
            [&](int r, int c4, f32x4 v) {
                f32x4 o; o.x = __shfl_xor(v.x, 16); o.y = __shfl_xor(v.y, 16); o.z = __shfl_xor(v.z, 16); o.w = __shfl_xor(v.w, 16);
                if (c4 < 64) { u32x2 w; w.x = pk2(silu(v.x) * o.x, silu(v.y) * o.y); w.y = pk2(silu(v.z) * o.z, silu(v.w) * o.w);
                    *(u32x2*)(hmid + (size_t)(m0 + r) * DEXP + j0 + c4) = w; }
            });
    }
}

__device__ __forceinline__ void st_moe2(Ctx& c, int l) {
    const float* WD = c.a->in[20] + (size_t)l * NEXP * DEXP * DM;
    for (int t = c.bid; t < (CAP / 64) * (DM / 128); t += c.nblk) {
        const int tn = t % (DM / 128), tm = t / (DM / 128), m0 = tm * 64, n0 = tn * 128;
        const int e = c_tile_e[m0 >> 8];
        if (e < 0) continue;
        const float* wd = WD + (size_t)e * DEXP * DM;
        const bf16_t* hmid = c_hmid; bf16_t* yexp = c_yexp;
        ngemm_tile(c.sm(), c.tid, DEXP,
            [&](int r, int k) { return bf2f(hmid[(size_t)(m0 + r) * DEXP + k]); },
            [&](int k, int c4) { return *(const f32x4*)(wd + (size_t)k * DM + n0 + c4); },
            [&](int r, int c4, f32x4 v) { u32x2 w; w.x = pk2(v.x, v.y); w.y = pk2(v.z, v.w); *(u32x2*)(yexp + (size_t)(m0 + r) * DM + n0 + c4) = w; });
    }
}

__device__ __forceinline__ void st_combine(Ctx& c, int l) {
    const float* g2 = c.a->in[21] + (size_t)l * DM; const float* b2 = c.a->in[22] + (size_t)l * DM;
    for (int m = c.gw(); m < MT; m += c.ngw()) {
        const int s0 = c_slot[m * 2], s1 = c_slot[m * 2 + 1]; const float w0 = c_gwt[m * 2], w1 = c_gwt[m * 2 + 1];
        f32x4 v[4];
#pragma unroll
        for (int j = 0; j < 4; ++j) {
            const int col = 4 * c.lane() + 256 * j;
            const f32x4 hv = *(const f32x4*)(c.h + (size_t)m * DM + col);
            const u32x2 a = *(const u32x2*)(c_yexp + (size_t)s0 * DM + col), b = *(const u32x2*)(c_yexp + (size_t)s1 * DM + col);
            f32x4 r;
            r.x = ALPHA * hv.x + w0 * lo16(a.x) + w1 * lo16(b.x); r.y = ALPHA * hv.y + w0 * hi16(a.x) + w1 * hi16(b.x);
            r.z = ALPHA * hv.z + w0 * lo16(a.y) + w1 * lo16(b.y); r.w = ALPHA * hv.w + w0 * hi16(a.y) + w1 * hi16(b.y);
            v[j] = r;
        }
        wave_ln_store(v, g2, b2, c.h + (size_t)m * DM, c_hb + (size_t)m * DM, c.lane());
    }
}

constexpr int PH_PER_LAYER = 10, N_PHASES = 1 + NLAYER * PH_PER_LAYER;

__global__ void __launch_bounds__(NTHR, 2) fwd(Args args) {
    extern __shared__ __attribute__((aligned(16))) unsigned char lds[];
    cg::grid_group grid = cg::this_grid();
    for (int ph = args.ph_lo; ph < args.ph_hi; ++ph) {
        Ctx c;
        int tid_ = threadIdx.x, bid_ = blockIdx.x, nblk_ = gridDim.x;
        unsigned char* ws_ = args.ws; float* out_ = args.out;
        asm volatile("" : "+v"(tid_), "+s"(bid_), "+s"(nblk_), "+s"(ws_), "+s"(out_));
        c.a = &args; c.tid = tid_; c.bid = bid_; c.nblk = nblk_; c.ws = ws_; c.h = out_; c.ldsp = (LAS unsigned char*)lds;
        if (ph == 0) { st_prologue(c); st_convert_common(c); st_convert_experts(c, 0); }
        else {
            const int l = (ph - 1) / PH_PER_LAYER, j = (ph - 1) % PH_PER_LAYER;
            switch (j) {
                case 0: st_zgemm_fast(c, l); break;
                case 1: st_diff_fast(c, l); st_na_fast(c, l); st_dil_fast(c); st_pool_fast(c, l); break;
                case 2: st_branch_fast(c, l); break;
                case 3: st_sum4(c); break;
                case 4: st_outgemm_fast(c, l); break;
                case 5: st_ln1_router(c, l); break;
                case 6: st_pack_fast(c, l); break;
                case 7: st_moe1_fast(c); break;
                case 8: st_moe2_fast(c); break;
                default: st_combine(c, l); if (l + 1 < NLAYER) st_convert_experts(c, l + 1); break;
            }
        }
        if (ph + 1 < args.ph_hi) grid.sync();
    }
}

extern "C" void kernel_launch(void* const* d_in, const int* in_sizes, int n_in, void* d_out, int out_size, void* d_ws, size_t ws_size, hipStream_t stream) {
    static int grid_blocks = 0;
    if (grid_blocks == 0) {
        if (n_in != 23 || out_size != MT * DM || ws_size < WS_END) { fprintf(stderr, "kernel_launch: unexpected shapes n_in %d out %d ws %zu\n", n_in, out_size, ws_size); grid_blocks = -1; return; }
        int dev = 0, cus = 0, per_cu = 0;
        hipGetDevice(&dev);
        hipDeviceGetAttribute(&cus, hipDeviceAttributeMultiprocessorCount, dev);
        hipFuncSetAttribute((const void*)fwd, hipFuncAttributeMaxDynamicSharedMemorySize, LDS_BYTES);
        hipOccupancyMaxActiveBlocksPerMultiprocessor(&per_cu, (const void*)fwd, NTHR, LDS_BYTES);
        if (per_cu < 1) { fprintf(stderr, "kernel_launch: occupancy query says %d blocks per CU\n", per_cu); per_cu = 1; }
        (void)hipGetLastError();
        grid_blocks = cus * per_cu;
    }
    if (grid_blocks < 0) return;
    hipMemsetAsync((char*)d_ws + WS_CTL, 0, CTL_BYTES, stream);
    Args a{};
    for (int i = 0; i < 23; ++i) a.in[i] = (const float*)d_in[i];
    a.out = (float*)d_out; a.ws = (unsigned char*)d_ws;
    for (int i = 0; i < 4; ++i) a.invf8[i] = exp((double)i * (-2.0 * log(500000.0) / 8.0));
    for (int i = 0; i < 8; ++i) a.invf16[i] = exp((double)i * (-2.0 * log(500000.0) / 16.0));
    a.ph_lo = 0; a.ph_hi = N_PHASES;
    void* kargs[] = {&a};
    hipError_t e = hipLaunchCooperativeKernel((const void*)fwd, dim3(grid_blocks), dim3(NTHR), kargs, LDS_BYTES, stream);
    if (e != hipSuccess) fprintf(stderr, "cooperative launch failed: %s (grid %d)\n", hipGetErrorString(e), grid_blocks);
}
```

```cpp
#include <hip/hip_runtime.h>
#include <hip/hip_cooperative_groups.h>
#include <cstdio>
#include <cstdint>
#include <cmath>
namespace cg = cooperative_groups;

constexpr int NB = 4, SEQ = 4096, DM = 1024, MT = NB * SEQ, NLAYER = 2;
constexpr int ZC = 4096, GC = 4096, INC = 8192;
constexpr int C_NAQ = 0, C_NAK = 256, C_NAV = 512, C_DFQ = 768, C_DFK = 1024, C_DFV = 1280, C_PL = 1536, C_DL = 1792;
constexpr int NEXP = 32, DEXP = 512, CAP = 40960, NTILE = CAP / 256;
constexpr float LN_EPS = 1e-5f;
constexpr float ALPHA = 1.41421356237309515f;
constexpr float LOG2E = 1.4426950408889634f;
constexpr float QS_64 = 0.125f * LOG2E, QS_32 = 0.17677669529663687f * LOG2E;

typedef unsigned short bf16_t;
typedef float f32x4 __attribute__((ext_vector_type(4)));
typedef unsigned u32x4 __attribute__((ext_vector_type(4)));
typedef unsigned u32x2 __attribute__((ext_vector_type(2)));

constexpr size_t MiB = 1u << 20;
constexpr size_t WS_CTL = 0, CTL_BYTES = 1 * MiB;
constexpr size_t WS_ROPE8 = 1 * MiB;
constexpr size_t WS_ROPE16 = WS_ROPE8 + 2 * 4096 * 4 * 4;
constexpr size_t WS_EID = 2 * MiB;
constexpr size_t WS_GW = WS_EID + (size_t)MT * 2 * 4;
constexpr size_t WS_SLOT = WS_GW + (size_t)MT * 2 * 4;
constexpr size_t WS_TOK = WS_SLOT + (size_t)MT * 2 * 4;
constexpr size_t WS_TILEE = WS_TOK + (size_t)CAP * 4;
constexpr size_t WS_PWT = 3 * MiB;
constexpr size_t WS_RPBT = 3 * MiB + 65536;
constexpr size_t WS_HB = 4 * MiB;
constexpr size_t WS_YS = 36 * MiB;
constexpr size_t WS_ZMIX = 68 * MiB;
constexpr size_t WS_GATES = 196 * MiB;
constexpr size_t WS_YPRE = 196 * MiB;
constexpr size_t WS_HMID = 148 * MiB;
constexpr size_t WS_YEXP = 260 * MiB;
constexpr size_t WS_XS = 68 * MiB;
constexpr size_t WS_WIN = 376 * MiB;
constexpr size_t WS_WBR = 408 * MiB;
constexpr size_t WS_WOUT = 412 * MiB;
constexpr size_t WS_WGU = 416 * MiB;
constexpr size_t WS_WD = 480 * MiB;
constexpr size_t WS_END = 512 * MiB;
constexpr int CW_CNT = 1024;
constexpr int CW_CUR = 1024 + 64;

constexpr int LDS_BYTES = 147456;
constexpr int NTHR = 512;

struct Args {
    const float* in[23];
    float* out;
    unsigned char* ws;
    double invf8[4];
    double invf16[8];
    int ph_lo, ph_hi;
};

__device__ __forceinline__ float bf2f(bf16_t v) { return __uint_as_float(((unsigned)v) << 16); }
__device__ __forceinline__ unsigned f2bf(float f) { unsigned u = __float_as_uint(f); return (u + 0x7fffu + ((u >> 16) & 1u)) >> 16; }
__device__ __forceinline__ unsigned pk2(float lo, float hi) { return f2bf(lo) | (f2bf(hi) << 16); }
__device__ __forceinline__ float lo16(unsigned w) { return __uint_as_float(w << 16); }
__device__ __forceinline__ float hi16(unsigned w) { return __uint_as_float(w & 0xffff0000u); }
__device__ __forceinline__ float wave_sum(float v) {
#pragma unroll
    for (int o = 1; o < 64; o <<= 1) v += __shfl_xor(v, o);
    return v;
}
__device__ __forceinline__ void wave_ln_store(f32x4 (&v)[4], const float* g, const float* bta, float* hrow, bf16_t* hbrow, int lane) {
    float s = 0.f;
#pragma unroll
    for (int j = 0; j < 4; ++j) s += (v[j].x + v[j].y) + (v[j].z + v[j].w);
    const float mean = wave_sum(s) * (1.f / DM);
    float s2 = 0.f;
#pragma unroll
    for (int j = 0; j < 4; ++j) { v[j] = v[j] - mean; s2 += (v[j].x * v[j].x + v[j].y * v[j].y) + (v[j].z * v[j].z + v[j].w * v[j].w); }
    const float rstd = 1.f / sqrtf(wave_sum(s2) * (1.f / DM) + LN_EPS);
#pragma unroll
    for (int j = 0; j < 4; ++j) {
        const int c = 4 * lane + 256 * j;
        const f32x4 gg = *(const f32x4*)(g + c), bb = *(const f32x4*)(bta + c);
        f32x4 o = v[j] * rstd * gg + bb;
        v[j] = o;
        *(f32x4*)(hrow + c) = o;
        u32x2 w; w.x = pk2(o.x, o.y); w.y = pk2(o.z, o.w);
        *(u32x2*)(hbrow + c) = w;
    }
}

template <class AF, class BF, class EF>
__device__ __forceinline__ void ngemm_tile(float* sm, const int tid, int K, AF af, BF bf, EF ef) {
    float* As = sm;
    float* Bs = sm + 16 * 68;
    const int tx = tid & 31, ty = tid >> 5;
    f32x4 acc[4];
#pragma unroll
    for (int i = 0; i < 4; ++i) acc[i] = (f32x4){0.f, 0.f, 0.f, 0.f};
    const int arow = tid >> 3, ak = (tid & 7) * 2, bk = tid >> 5, bc = (tid & 31) * 4;
    for (int k0 = 0; k0 < K; k0 += 16) {
        const float a0 = af(arow, k0 + ak), a1 = af(arow, k0 + ak + 1);
        const f32x4 b = bf(k0 + bk, bc);
        __syncthreads();
        As[ak * 68 + arow] = a0; As[(ak + 1) * 68 + arow] = a1;
        *(f32x4*)(Bs + bk * 128 + bc) = b;
        __syncthreads();
#pragma unroll
        for (int kk = 0; kk < 16; ++kk) {
            const f32x4 a = *(const f32x4*)(As + kk * 68 + ty * 4);
            const f32x4 bb = *(const f32x4*)(Bs + kk * 128 + tx * 4);
            acc[0] += a.x * bb; acc[1] += a.y * bb; acc[2] += a.z * bb; acc[3] += a.w * bb;
        }
    }
#pragma unroll
    for (int i = 0; i < 4; ++i) ef(ty * 4 + i, tx * 4, acc[i]);
}


namespace pg8 {
#define PG8_LAS __attribute__((address_space(3)))
typedef short bf16x8 __attribute__((ext_vector_type(8)));
constexpr int BM = 256, BK = 64, HALF = 128, HTB = HALF * BK * 2, STAGE_BYTES = 8 * HTB, NXCD = 8, WGM = 8;
__host__ __device__ __forceinline__ int lds_byte(int r, int c) { const int st = (r >> 4) * 2 + (c >> 5), rr = r & 15, cc = c & 31, ob = rr * 64 + cc * 2; return st * 1024 + (ob ^ (((ob >> 9) & 1) << 5)); }
__host__ __device__ __forceinline__ void stage_rc(int b, int& R, int& C) { const int st = b / 1024, sb = b % 1024, swz = sb ^ (((sb >> 9) & 1) << 5); R = (st >> 1) * 16 + swz / 64; C = (st & 1) * 32 + (swz % 64) / 2; }
__host__ __device__ __forceinline__ int perm32(int rho) { const int n = rho >> 4, i = rho & 15; return 8 * (i >> 2) + 4 * n + (i & 3); }

struct Unit { int pm, pn; size_t a_off, b_off; };
struct Gemm { const bf16_t* A; const bf16_t* Bt; int lda, ldb, K; };

__device__ __forceinline__ unsigned cvt_pk_bf16(float lo, float hi) { unsigned r; asm volatile("v_cvt_pk_bf16_f32 %0, %1, %2" : "=v"(r) : "v"(lo), "v"(hi)); return r; }

struct TileOrder {
    int nM, nN, nwg, G, c;
    __device__ void init(int nM_, int nN_, int G_, int c_) { nM = nM_; nN = nN_; nwg = nM * nN; G = G_; c = c_; }
    __device__ bool tile(int i, int& pm, int& pn) const {
        const long L = (long)i * G + c; if (L >= nwg) return false;
        int wgid = (int)L; { const int q = nwg / NXCD, r = nwg % NXCD, xcd = wgid % NXCD, off = wgid / NXCD; wgid = (xcd < r ? xcd * (q + 1) : r * (q + 1) + (xcd - r) * q) + off; }
        const int nig = WGM * nN, gid = wgid / nig, fm = gid * WGM, gsz = (nM - fm) < WGM ? (nM - fm) : WGM;
        pm = fm + ((wgid % nig) % gsz); pn = (wgid % nig) / gsz; return true;
    }
};

template <class Epi, class Sched, bool ALIGN_EPI>
__device__ __forceinline__ void gemm_phase(PG8_LAS unsigned char* lds, const Gemm g, const Sched& S, const Epi& E, const int tid) {
    const int wid = __builtin_amdgcn_readfirstlane(tid >> 6), lane = tid & 63, wr = wid >> 2, wc = wid & 3, fr = lane & 15, fq = lane >> 4;
    int K = g.K, lda = g.lda, ldb = g.ldb; asm volatile("" : "+s"(K), "+s"(lda), "+s"(ldb));
    const int nt = K / BK;
    unsigned voffA[2], voffB[2];
#pragma unroll
    for (int i = 0; i < 2; ++i) { int R, C; stage_rc(tid * 16 + i * 8192, R, C); const int Rb = Epi::PERM ? ((R & ~31) + perm32(R & 31)) : R;
        voffA[i] = (unsigned)(R * lda + C) * 2u; voffB[i] = (unsigned)(Rb * ldb + C) * 2u; }
    const size_t kstep = (size_t)(BK * 2);
    const size_t hstepA = (size_t)HALF * lda * 2, hstepB = (size_t)HALF * ldb * 2;
    const unsigned ldsw = (unsigned)wid * 1024u;
    const int aoff = lds_byte(wr * 64 + fr, fq * 8), boff = lds_byte(wc * 32 + fr, fq * 8);
#define PG8_SA(b, h) (((b) * 2 + (h)) * HTB)
#define PG8_SB(b, h) ((4 + (b) * 2 + (h)) * HTB)
#define PG8_STAGE(bufoff, gbase, voff) do { _Pragma("unroll") for (int _i = 0; _i < 2; ++_i) \
        __builtin_amdgcn_global_load_lds((const unsigned*)((const char*)(gbase) + (voff)[_i]), (PG8_LAS unsigned*)(lds + (bufoff) + ldsw + _i * 8192), 16, 0, 0); } while (0)
#define PG8_LDA(dst, b, h) do { _Pragma("unroll") for (int m = 0; m < 4; ++m) _Pragma("unroll") for (int k = 0; k < 2; ++k) dst[m][k] = *(const PG8_LAS bf16x8*)(lds + PG8_SA(b, h) + aoff + m * 2048 + k * 1024); } while (0)
#define PG8_LDB(dst, b, h) do { _Pragma("unroll") for (int n = 0; n < 2; ++n) _Pragma("unroll") for (int k = 0; k < 2; ++k) dst[n][k] = *(const PG8_LAS bf16x8*)(lds + PG8_SB(b, h) + boff + n * 2048 + k * 1024); } while (0)
#define PG8_MMA(ai, bj, At, Bt) do { __builtin_amdgcn_s_setprio(1); _Pragma("unroll") for (int m = 0; m < 4; ++m) _Pragma("unroll") for (int n = 0; n < 2; ++n) _Pragma("unroll") for (int k = 0; k < 2; ++k) \
        acc[ai][bj][m][n] = __builtin_amdgcn_mfma_f32_16x16x32_bf16(Bt[n][k], At[m][k], acc[ai][bj][m][n], 0, 0, 0); __builtin_amdgcn_s_setprio(0); } while (0)
#define PG8_WAIT_V(n) asm volatile("s_waitcnt vmcnt(" #n ")" ::: "memory")
#define PG8_WAIT_L(n) asm volatile("s_waitcnt lgkmcnt(" #n ")" ::: "memory")
#define PG8_BAR __builtin_amdgcn_s_barrier()
#define PG8_SCHED __builtin_amdgcn_sched_barrier(0)
    Unit cur, nxt; int ui = 0;
    if (!S.next(0, cur)) return;
    f32x4 acc[2][2][4][2];
#pragma unroll
    for (int a = 0; a < 2; ++a)
#pragma unroll
        for (int b = 0; b < 2; ++b)
#pragma unroll
            for (int m = 0; m < 4; ++m)
#pragma unroll
                for (int n = 0; n < 2; ++n) acc[a][b][m][n] = (f32x4){0.f, 0.f, 0.f, 0.f};
    bf16x8 At[4][2], B0[2][2], B1[2][2];
    const char* cA = (const char*)g.A + cur.a_off; const char* cB = (const char*)g.Bt + cur.b_off;
    PG8_STAGE(PG8_SB(0, 0), cB, voffB); PG8_STAGE(PG8_SB(0, 1), cB + hstepB, voffB); PG8_STAGE(PG8_SA(0, 0), cA, voffA); PG8_STAGE(PG8_SA(0, 1), cA + hstepA, voffA);
    if (wr == 1) PG8_BAR;
    PG8_WAIT_V(2); PG8_BAR;
    PG8_STAGE(PG8_SB(1, 0), cB + kstep, voffB); PG8_STAGE(PG8_SA(1, 0), cA + kstep, voffA); PG8_STAGE(PG8_SB(1, 1), cB + hstepB + kstep, voffB);
    PG8_WAIT_V(6); PG8_BAR;
    for (;;) {
        const bool has_next = S.next(ui + 1, nxt);
        const char* nA = has_next ? (const char*)g.A + nxt.a_off : cA; const char* nB = has_next ? (const char*)g.Bt + nxt.b_off : cB;
        for (int t = 0; t < nt; t += 2) {
            const bool last = (t == nt - 2);
            const char* a1 = cA + (size_t)(t + 1) * kstep;
            const char* a2 = last ? nA : cA + (size_t)(t + 2) * kstep; const char* b2 = last ? nB : cB + (size_t)(t + 2) * kstep;
            const char* a3 = a2 + kstep; const char* b3 = b2 + kstep;
            PG8_LDB(B0, 0, 0); PG8_LDB(B1, 0, 1); PG8_SCHED; PG8_LDA(At, 0, 0); PG8_STAGE(PG8_SA(1, 1), a1 + hstepA, voffA);
            PG8_WAIT_V(8); PG8_WAIT_L(0); PG8_BAR; PG8_MMA(0, 0, At, B0); PG8_MMA(0, 1, At, B1); PG8_BAR; PG8_SCHED;
            PG8_LDA(At, 0, 1); PG8_STAGE(PG8_SB(0, 0), b2, voffB); PG8_STAGE(PG8_SB(0, 1), b2 + hstepB, voffB); PG8_STAGE(PG8_SA(0, 0), a2, voffA);
            PG8_WAIT_V(8); PG8_WAIT_L(0); PG8_BAR; PG8_MMA(1, 0, At, B0); PG8_MMA(1, 1, At, B1); PG8_BAR; PG8_SCHED;
            PG8_LDB(B0, 1, 0); PG8_LDB(B1, 1, 1); PG8_SCHED; PG8_LDA(At, 1, 0); PG8_STAGE(PG8_SA(0, 1), a2 + hstepA, voffA);
            PG8_WAIT_V(8); PG8_WAIT_L(0); PG8_BAR; PG8_MMA(0, 0, At, B0); PG8_MMA(0, 1, At, B1); PG8_BAR; PG8_SCHED;
            PG8_LDA(At, 1, 1); PG8_STAGE(PG8_SB(1, 0), b3, voffB); PG8_STAGE(PG8_SB(1, 1), b3 + hstepB, voffB); PG8_STAGE(PG8_SA(1, 0), a3, voffA);
            PG8_WAIT_V(8); PG8_WAIT_L(0); PG8_BAR; PG8_MMA(1, 0, At, B0); PG8_MMA(1, 1, At, B1); PG8_BAR; PG8_SCHED;
        }
        if constexpr (ALIGN_EPI) { if (wr == 0) PG8_BAR; }
        E(acc, cur, wr, wc, fr, fq);
        if (!has_next) break;
#pragma unroll
        for (int a = 0; a < 2; ++a)
#pragma unroll
            for (int b = 0; b < 2; ++b)
#pragma unroll
                for (int m = 0; m < 4; ++m)
#pragma unroll
                    for (int n = 0; n < 2; ++n) acc[a][b][m][n] = (f32x4){0.f, 0.f, 0.f, 0.f};
        cur = nxt; cA = nA; cB = nB; ++ui;
        if constexpr (ALIGN_EPI) { if (wr == 1) PG8_BAR; }
    }
    PG8_WAIT_V(0);
    if constexpr (!ALIGN_EPI) { if (wr == 0) PG8_BAR; }
    PG8_BAR;
#undef PG8_SA
#undef PG8_SB
#undef PG8_STAGE
#undef PG8_LDA
#undef PG8_LDB
#undef PG8_MMA
#undef PG8_WAIT_V
#undef PG8_WAIT_L
#undef PG8_BAR
#undef PG8_SCHED
}
}
#define LAS __attribute__((address_space(3)))
#define GAS __attribute__((address_space(1)))

struct Ctx {
    const Args* a; int tid, bid, nblk; unsigned char* ws; float* h; LAS unsigned char* ldsp;
    __device__ __forceinline__ int lane() const { return tid & 63; }
    __device__ __forceinline__ int wave() const { return tid >> 6; }
    __device__ __forceinline__ int gw() const { return bid * (NTHR / 64) + (tid >> 6); }
    __device__ __forceinline__ int ngw() const { return nblk * (NTHR / 64); }
    __device__ __forceinline__ long gtid() const { return (long)bid * NTHR + tid; }
    __device__ __forceinline__ long ngt() const { return (long)nblk * NTHR; }
    __device__ __forceinline__ float* sm() const { return (float*)ldsp; }
};
#define c_hb     ((bf16_t*)(c.ws + WS_HB))
#define c_merged ((bf16_t*)(c.ws + WS_HB))
#define c_ys     ((bf16_t*)(c.ws + WS_YS))
#define c_zmix   ((bf16_t*)(c.ws + WS_ZMIX))
#define c_gates  ((bf16_t*)(c.ws + WS_GATES))
#define c_ypre   ((float*)(c.ws + WS_YPRE))
#define c_hmid   ((bf16_t*)(c.ws + WS_HMID))
#define c_yexp   ((bf16_t*)(c.ws + WS_YEXP))
#define c_eid    ((int*)(c.ws + WS_EID))
#define c_gwt    ((float*)(c.ws + WS_GW))
#define c_slot   ((int*)(c.ws + WS_SLOT))
#define c_tok    ((int*)(c.ws + WS_TOK))
#define c_tile_e ((int*)(c.ws + WS_TILEE))
#define c_ctl    ((unsigned*)(c.ws + WS_CTL))
#define c_rc8    ((float*)(c.ws + WS_ROPE8))
#define c_rs8    ((float*)(c.ws + WS_ROPE8) + 4096 * 4)
#define c_rc16   ((float*)(c.ws + WS_ROPE16))
#define c_rs16   ((float*)(c.ws + WS_ROPE16) + 4096 * 8)
#define c_pwt    ((bf16_t*)(c.ws + WS_PWT))
#define c_rpbt   ((float*)(c.ws + WS_RPBT))
#define c_xs     ((bf16_t*)(c.ws + WS_XS))
#define c_win    ((bf16_t*)(c.ws + WS_WIN))
#define c_wbr    ((bf16_t*)(c.ws + WS_WBR))
#define c_wout   ((bf16_t*)(c.ws + WS_WOUT))
#define c_wgu    ((bf16_t*)(c.ws + WS_WGU))
#define c_wd     ((bf16_t*)(c.ws + WS_WD))

__device__ __forceinline__ void st_prologue(Ctx& c) {
    const Args& A = *c.a;
    for (long i = c.gtid(); i < 4096; i += c.ngt()) {
        const int pos = (int)i;
#pragma unroll
        for (int j = 0; j < 12; ++j) {
            const double f = j < 4 ? A.invf8[j < 4 ? j : 0] : A.invf16[j < 4 ? 0 : j - 4];
            const double ang = (double)pos * f;
            const double kk = __builtin_rint(ang * 0.15915494309189535);
            const float r = (float)(ang - kk * 6.283185307179586);
            const float cs = cosf(r), sn = sinf(r);
            if (j < 4) { c_rc8[pos * 4 + j] = cs; c_rs8[pos * 4 + j] = sn; }
            else { c_rc16[pos * 8 + j - 4] = cs; c_rs16[pos * 8 + j - 4] = sn; }
        }
    }
    for (long i = c.gtid(); i < 2 * 4 * 64 * 64; i += c.ngt()) { const int cc = (int)(i & 63), e = (int)((i >> 6) & 63), lg = (int)(i >> 12);
        c_pwt[i] = (bf16_t)f2bf(A.in[8][((size_t)lg * 64 + cc) * 64 + e]); }
    for (long i = c.gtid(); i < 2 * 4 * 15 * 31; i += c.ngt()) c_rpbt[i] = A.in[5][i] * LOG2E;
    const float* x = A.in[0];
    for (int m = c.gw(); m < MT; m += c.ngw()) {
        f32x4 v[4];
#pragma unroll
        for (int j = 0; j < 4; ++j) v[j] = *(const f32x4*)(x + (size_t)m * DM + 4 * c.lane() + 256 * j);
        wave_ln_store(v, A.in[1], A.in[2], c.h + (size_t)m * DM, c_hb + (size_t)m * DM, c.lane());
    }
}

__device__ __forceinline__ void st_zgemm(Ctx& c, int l) {
    const float* W = c.a->in[3] + (size_t)l * DM * INC;
    const float* bg = c.a->in[4] + (size_t)l * GC;
    for (int t = c.bid; t < (MT / 64) * (INC / 128); t += c.nblk) {
        const int tn = t % (INC / 128), tm = t / (INC / 128), m0 = tm * 64, n0 = tn * 128;
        const bf16_t* hb = c_hb; bf16_t* zmix = c_zmix; bf16_t* gates = c_gates;
        ngemm_tile(c.sm(), c.tid, DM,
            [&](int r, int k) { return bf2f(hb[(size_t)(m0 + r) * DM + k]); },
            [&](int k, int c4) { return *(const f32x4*)(W + (size_t)k * INC + n0 + c4); },
            [&](int r, int c4, f32x4 v) {
                const int col = n0 + c4; const size_t row = (size_t)(m0 + r);
                if (col < ZC) { u32x2 w; w.x = pk2(v.x, v.y); w.y = pk2(v.z, v.w); *(u32x2*)(zmix + row * ZC + col) = w; }
                else { const f32x4 b = *(const f32x4*)(bg + col - ZC); f32x4 s;
                    s.x = 1.f / (1.f + __expf(-(v.x + b.x))); s.y = 1.f / (1.f + __expf(-(v.y + b.y)));
                    s.z = 1.f / (1.f + __expf(-(v.z + b.z))); s.w = 1.f / (1.f + __expf(-(v.w + b.w)));
                    u32x2 w; w.x = pk2(s.x, s.y); w.y = pk2(s.z, s.w); *(u32x2*)(gates + row * GC + col - ZC) = w; }
            });
    }
}


__device__ __forceinline__ void transpose_item(const float* W, int K, int N, bf16_t* WT, int kb, int n0, size_t out_row0, LAS float* scr, int lane) {
    const int k0 = 64 * kb;
#pragma unroll 8
    for (int i = 0; i < 32; ++i) { const int kk = 2 * i + (lane >> 5); scr[kk * 33 + (lane & 31)] = W[(size_t)(k0 + kk) * N + n0 + (lane & 31)]; }
    asm volatile("s_waitcnt lgkmcnt(0)" ::: "memory");
    const int cc = lane & 7;
#pragma unroll
    for (int j = 0; j < 4; ++j) { const int n = (lane >> 3) + 8 * j; const LAS float* sp = scr + (8 * cc) * 33 + n;
        u32x4 o; o.x = pk2(sp[0 * 33], sp[1 * 33]); o.y = pk2(sp[2 * 33], sp[3 * 33]); o.z = pk2(sp[4 * 33], sp[5 * 33]); o.w = pk2(sp[6 * 33], sp[7 * 33]);
        *(u32x4*)(WT + (out_row0 + n) * K + k0 + 8 * cc) = o; }
    asm volatile("s_waitcnt lgkmcnt(0)" ::: "memory");
}
__device__ __forceinline__ void st_convert_common(Ctx& c) {
    LAS float* scr = (LAS float*)(c.ldsp + c.wave() * 16384);
    const float* w_in = c.a->in[3]; const float* w_br = c.a->in[10]; const float* w_out = c.a->in[11];
    constexpr int I_IN = 2 * 16 * 256, I_BR = 8 * 128, I_OUT = 2 * 512;
    for (int it = c.gw(); it < I_IN + I_BR + I_OUT; it += c.ngw()) {
        int r = it;
        if (r < I_IN) { const int l = r / 4096, q = r % 4096, kb = q / 256, nb = q % 256;
            transpose_item(w_in + (size_t)l * DM * INC, DM, INC, c_win + (size_t)l * INC * DM, kb, nb * 32, (size_t)nb * 32, scr, c.lane()); continue; }
        r -= I_IN;
        if (r < I_BR) { const int mtx = r / 128, q = r % 128, kb = q / 32, nb = q % 32;
            transpose_item(w_br + (size_t)mtx * 256 * DM, 256, DM, c_wbr, kb, nb * 32, (size_t)mtx * 1024 + nb * 32, scr, c.lane()); continue; }
        r -= I_BR;
        { const int l = r / 512, q = r % 512, kb = q / 32, nb = q % 32;
            transpose_item(w_out + (size_t)l * DM * DM, DM, DM, c_wout + (size_t)l * DM * DM, kb, nb * 32, (size_t)nb * 32, scr, c.lane()); }
    }
}
__device__ __forceinline__ void st_convert_experts(Ctx& c, int l) {
    LAS float* scr = (LAS float*)(c.ldsp + c.wave() * 16384);
    const float* WG = c.a->in[18] + (size_t)l * NEXP * DM * DEXP; const float* WU = c.a->in[19] + (size_t)l * NEXP * DM * DEXP; const float* WD = c.a->in[20] + (size_t)l * NEXP * DEXP * DM;
    constexpr int I_GU = NEXP * 2 * 256, I_D = NEXP * 256;
    for (int it = c.gw(); it < I_GU + I_D; it += c.ngw()) {
        int r = it;
        if (r < I_GU) { const int e = r / 512, q = r % 512, which = q / 256, q2 = q % 256, kb = q2 / 16, nb = q2 % 16, n0 = nb * 32;
            const float* W = (which ? WU : WG) + (size_t)e * DM * DEXP;
            transpose_item(W, DM, DEXP, c_wgu, kb, n0, (size_t)e * 1024 + (n0 / 128) * 256 + which * 128 + (n0 % 128), scr, c.lane()); continue; }
        r -= I_GU;
        { const int e = r / 256, q = r % 256, kb = q / 32, nb = q % 32;
            transpose_item(WD + (size_t)e * DEXP * DM, DEXP, DM, c_wd, kb, nb * 32, (size_t)e * 1024 + nb * 32, scr, c.lane()); }
    }
}

struct EpiZ {
    static constexpr bool PERM = true;
    bf16_t* zmix; bf16_t* gates; const float* bgate; const float* rc8; const float* rs8; const float* rc16; const float* rs16;
    __device__ __forceinline__ void operator()(const f32x4 (&acc)[2][2][4][2], const pg8::Unit& u, int wr, int wc, int fr, int fq) const {
        const int row0 = u.pm * 256 + wr * 64 + fr, pn = u.pn;
        if (pn >= 16) {
            const int col0 = (pn - 16) * 256 + wc * 32 + 8 * fq;
            f32x4 bv[2][2];
#pragma unroll
            for (int bj = 0; bj < 2; ++bj)
#pragma unroll
                for (int n = 0; n < 2; ++n) bv[bj][n] = *(const f32x4*)(bgate + col0 + bj * 128 + 4 * n);
#pragma unroll
            for (int ai = 0; ai < 2; ++ai)
#pragma unroll
                for (int m = 0; m < 4; ++m) { bf16_t* rowp = gates + (size_t)(row0 + ai * 128 + m * 16) * GC + col0;
#pragma unroll
                    for (int bj = 0; bj < 2; ++bj) { const f32x4 v0 = acc[ai][bj][m][0] + bv[bj][0], v1 = acc[ai][bj][m][1] + bv[bj][1];
                        u32x4 w;
                        w.x = pg8::cvt_pk_bf16(1.f / (1.f + __expf(-v0.x)), 1.f / (1.f + __expf(-v0.y))); w.y = pg8::cvt_pk_bf16(1.f / (1.f + __expf(-v0.z)), 1.f / (1.f + __expf(-v0.w)));
                        w.z = pg8::cvt_pk_bf16(1.f / (1.f + __expf(-v1.x)), 1.f / (1.f + __expf(-v1.y))); w.w = pg8::cvt_pk_bf16(1.f / (1.f + __expf(-v1.z)), 1.f / (1.f + __expf(-v1.w)));
                        *(u32x4*)(rowp + bj * 128) = w; } }
        } else {
            const int col0 = pn * 256 + wc * 32 + 8 * fq;
            const float qs = (pn == 0 || pn == 7 || pn == 10 || pn == 13) ? QS_64 : (pn == 3 ? QS_32 : 1.f);
            const bool r8 = (pn == 3 || pn == 4);
            const bool r16 = (pn >= 7) && (((pn - 7) % 3) != 2) && ((wc & 1) == 0);
#pragma unroll
            for (int ai = 0; ai < 2; ++ai)
#pragma unroll
                for (int m = 0; m < 4; ++m) { const int row = row0 + ai * 128 + m * 16, pos = row & (SEQ - 1); bf16_t* rowp = zmix + (size_t)row * ZC + col0;
#pragma unroll
                    for (int bj = 0; bj < 2; ++bj) { f32x4 v0 = acc[ai][bj][m][0], v1 = acc[ai][bj][m][1];
                        if (r8) {
                            if (fq == 0) { const f32x4 cs = *(const f32x4*)(rc8 + pos * 4), sn = *(const f32x4*)(rs8 + pos * 4);
                                const f32x4 n0 = v0 * cs - v1 * sn, n1 = v0 * sn + v1 * cs; v0 = n0; v1 = n1; }
                        } else if (r16) {
                            f32x4 o0, o1;
                            o0.x = __shfl_xor(v0.x, 16); o0.y = __shfl_xor(v0.y, 16); o0.z = __shfl_xor(v0.z, 16); o0.w = __shfl_xor(v0.w, 16);
                            o1.x = __shfl_xor(v1.x, 16); o1.y = __shfl_xor(v1.y, 16); o1.z = __shfl_xor(v1.z, 16); o1.w = __shfl_xor(v1.w, 16);
                            if (fq < 2) { const f32x4 c0 = *(const f32x4*)(rc16 + pos * 8), c1 = *(const f32x4*)(rc16 + pos * 8 + 4), s0 = *(const f32x4*)(rs16 + pos * 8), s1 = *(const f32x4*)(rs16 + pos * 8 + 4);
                                if (fq == 0) { v0 = v0 * c0 - o0 * s0; v1 = v1 * c1 - o1 * s1; }
                                else { v0 = o0 * s0 + v0 * c0; v1 = o1 * s1 + v1 * c1; } }
                        }
                        v0 = v0 * qs; v1 = v1 * qs;
                        u32x4 w; w.x = pg8::cvt_pk_bf16(v0.x, v0.y); w.y = pg8::cvt_pk_bf16(v0.z, v0.w); w.z = pg8::cvt_pk_bf16(v1.x, v1.y); w.w = pg8::cvt_pk_bf16(v1.z, v1.w);
                        *(u32x4*)(rowp + bj * 128) = w; } }
        }
    }
};
struct ZSched {
    pg8::TileOrder T;
    __device__ __forceinline__ bool next(int i, pg8::Unit& u) const { int pm, pn; if (!T.tile(i, pm, pn)) return false; u.pm = pm; u.pn = pn;
        u.a_off = (size_t)pm * 256 * DM * 2; u.b_off = (size_t)pn * 256 * DM * 2; return true; }
};
__device__ __forceinline__ void st_zgemm_fast(Ctx& c, int l) {
    pg8::Gemm g{c_hb, c_win + (size_t)l * INC * DM, DM, DM, DM};
    ZSched S; S.T.init(MT / 256, INC / 256, c.nblk, c.bid);
    EpiZ E{c_zmix, c_gates, c.a->in[4] + (size_t)l * GC, c_rc8, c_rs8, c_rc16, c_rs16};
    pg8::gemm_phase<EpiZ, ZSched, true>(c.ldsp, g, S, E, c.tid);
}


struct EpiBr {
    static constexpr bool PERM = true;
    bf16_t* gp; const bf16_t* gates;
    __device__ __forceinline__ void operator()(const f32x4 (&acc)[2][2][4][2], const pg8::Unit& u, int wr, int wc, int fr, int fq) const {
        const int row0 = u.pm * 256 + wr * 64 + fr, col0 = u.pn * 256 + wc * 32 + 8 * fq;
#pragma unroll
        for (int ai = 0; ai < 2; ++ai)
#pragma unroll
            for (int m = 0; m < 4; ++m) { const size_t off = (size_t)(row0 + ai * 128 + m * 16) * GC + col0;
#pragma unroll
                for (int bj = 0; bj < 2; ++bj) { const u32x4 g = *(const u32x4*)(gates + off + bj * 128); const f32x4 v0 = acc[ai][bj][m][0], v1 = acc[ai][bj][m][1];
                    u32x4 w; w.x = pg8::cvt_pk_bf16(v0.x * lo16(g.x), v0.y * hi16(g.x)); w.y = pg8::cvt_pk_bf16(v0.z * lo16(g.y), v0.w * hi16(g.y));
                    w.z = pg8::cvt_pk_bf16(v1.x * lo16(g.z), v1.y * hi16(g.z)); w.w = pg8::cvt_pk_bf16(v1.z * lo16(g.w), v1.w * hi16(g.w));
                    *(u32x4*)(gp + off + bj * 128) = w; }
                asm volatile("" ::: "memory"); }
    }
};
struct BrSched {
    pg8::TileOrder T;
    __device__ __forceinline__ bool next(int i, pg8::Unit& u) const { int pm, pn; if (!T.tile(i, pm, pn)) return false; u.pm = pm; u.pn = pn;
        u.a_off = (size_t)pm * 256 * DM * 2 + (size_t)(pn >> 2) * 256 * 2; u.b_off = (size_t)pn * 256 * 256 * 2; return true; }
};
__device__ __forceinline__ void st_branch_fast(Ctx& c, int l) {
    pg8::Gemm g{c_ys, c_wbr + (size_t)l * 4096 * 256, DM, 256, 256};
    BrSched S; S.T.init(MT / 256, 16, c.nblk, c.bid);
    EpiBr E{c_zmix, c_gates};
    pg8::gemm_phase<EpiBr, BrSched, true>(c.ldsp, g, S, E, c.tid);
}
__device__ __forceinline__ void st_sum4(Ctx& c) {
    const bf16_t* gp = c_zmix; bf16_t* mg = c_merged;
    for (long i = c.gtid(); i < (long)MT * 128; i += c.ngt()) {
        const size_t t = (size_t)(i >> 7); const int d = (int)(i & 127) * 8;
        const u32x4 a = *(const u32x4*)(gp + t * GC + d), b = *(const u32x4*)(gp + t * GC + 1024 + d), cc = *(const u32x4*)(gp + t * GC + 2048 + d), dd = *(const u32x4*)(gp + t * GC + 3072 + d);
        u32x4 w;
        w.x = pk2((lo16(a.x) + lo16(b.x)) + (lo16(cc.x) + lo16(dd.x)), (hi16(a.x) + hi16(b.x)) + (hi16(cc.x) + hi16(dd.x)));
        w.y = pk2((lo16(a.y) + lo16(b.y)) + (lo16(cc.y) + lo16(dd.y)), (hi16(a.y) + hi16(b.y)) + (hi16(cc.y) + hi16(dd.y)));
        w.z = pk2((lo16(a.z) + lo16(b.z)) + (lo16(cc.z) + lo16(dd.z)), (hi16(a.z) + hi16(b.z)) + (hi16(cc.z) + hi16(dd.z)));
        w.w = pk2((lo16(a.w) + lo16(b.w)) + (lo16(cc.w) + lo16(dd.w)), (hi16(a.w) + hi16(b.w)) + (hi16(cc.w) + hi16(dd.w)));
        *(u32x4*)(mg + t * DM + d) = w;
    }
}
struct EpiOut {
    static constexpr bool PERM = false;
    const float* h; float* ypre;
    __device__ __forceinline__ void operator()(const f32x4 (&acc)[2][2][4][2], const pg8::Unit& u, int wr, int wc, int fr, int fq) const {
        const int row0 = u.pm * 256 + wr * 64 + fr, col0 = u.pn * 256 + wc * 32 + 4 * fq;
#pragma unroll
        for (int ai = 0; ai < 2; ++ai)
#pragma unroll
            for (int m = 0; m < 4; ++m) { const size_t off = (size_t)(row0 + ai * 128 + m * 16) * DM + col0;
#pragma unroll
                for (int bj = 0; bj < 2; ++bj)
#pragma unroll
                    for (int n = 0; n < 2; ++n) { const f32x4 hv = *(const f32x4*)(h + off + bj * 128 + n * 16); *(f32x4*)(ypre + off + bj * 128 + n * 16) = ALPHA * hv + acc[ai][bj][m][n]; }
                asm volatile("" ::: "memory"); }
    }
};
struct OutSched {
    pg8::TileOrder T;
    __device__ __forceinline__ bool next(int i, pg8::Unit& u) const { int pm, pn; if (!T.tile(i, pm, pn)) return false; u.pm = pm; u.pn = pn;
        u.a_off = (size_t)pm * 256 * DM * 2; u.b_off = (size_t)pn * 256 * DM * 2; return true; }
};
__device__ __forceinline__ void st_outgemm_fast(Ctx& c, int l) {
    pg8::Gemm g{c_merged, c_wout + (size_t)l * DM * DM, DM, DM, DM};
    OutSched S; S.T.init(MT / 256, DM / 256, c.nblk, c.bid);
    EpiOut E{c.h, c_ypre};
    pg8::gemm_phase<EpiOut, OutSched, true>(c.ldsp, g, S, E, c.tid);
}
__device__ __forceinline__ void st_pack_fast(Ctx& c, int l) {
    unsigned* cnt = c_ctl + CW_CNT + l * 32; unsigned* cur = c_ctl + CW_CUR + l * 32;
    int* offs = (int*)c.sm();
    if (c.tid == 0) { int o = 0; for (int e = 0; e < NEXP; ++e) { offs[e] = o; const int n = (int)__hip_atomic_load(cnt + e, __ATOMIC_RELAXED, __HIP_MEMORY_SCOPE_AGENT); o += (n + 255) / 256 * 256; } offs[32] = o; }
    __syncthreads();
    if (c.bid == 0) {
        for (int i = c.tid; i <= NTILE; i += NTHR) { const int row = i * 256; int e = -1;
            if (i == NTILE) e = offs[32] / 256;
            else if (row < offs[32]) { e = 0; for (int q = 1; q < NEXP; ++q) if (row >= offs[q]) e = q; }
            c_tile_e[i] = e; }
    }
    const int lane = c.lane();
    for (int i = c.gw(); i < MT * 2; i += c.ngw()) {
        int pos = 0;
        if (lane == 0) { const int e = c_eid[i]; pos = offs[e] + (int)atomicAdd(cur + e, 1u); c_slot[i] = pos; c_tok[pos] = i >> 1; }
        pos = __builtin_amdgcn_readfirstlane(pos);
        const u32x4* src = (const u32x4*)(c_hb + (size_t)(i >> 1) * DM); u32x4* dst = (u32x4*)(c_xs + (size_t)pos * DM);
        const u32x4 a = src[lane], b = src[lane + 64];
        dst[lane] = a; dst[lane + 64] = b;
    }
    __syncthreads();
}
struct MoeSched {
    const int* tile_e; int G, c; int lda_bytes_tile, b_tile_bytes, b_exp_bytes;
    __device__ __forceinline__ bool next(int i, pg8::Unit& u) const {
        const int L = i * G + c, pm = L >> 2, pn = L & 3;
        if (pm >= NTILE) return false;
        const int e = __builtin_amdgcn_readfirstlane(tile_e[pm]);
        if (e < 0) return false;
        u.pm = pm; u.pn = pn; u.a_off = (size_t)pm * lda_bytes_tile; u.b_off = (size_t)e * b_exp_bytes + (size_t)pn * b_tile_bytes; return true; }
};
__device__ __forceinline__ float silu_f(float x) { return x / (1.f + __expf(-x)); }
struct EpiMoe1 {
    static constexpr bool PERM = true;
    bf16_t* hmid;
    __device__ __forceinline__ void operator()(const f32x4 (&acc)[2][2][4][2], const pg8::Unit& u, int wr, int wc, int fr, int fq) const {
        const int row0 = u.pm * 256 + wr * 64 + fr, col0 = u.pn * 128 + wc * 32 + 8 * fq;
#pragma unroll
        for (int ai = 0; ai < 2; ++ai)
#pragma unroll
            for (int m = 0; m < 4; ++m) { const f32x4 g0 = acc[ai][0][m][0], g1 = acc[ai][0][m][1], u0 = acc[ai][1][m][0], u1 = acc[ai][1][m][1];
                u32x4 w; w.x = pg8::cvt_pk_bf16(silu_f(g0.x) * u0.x, silu_f(g0.y) * u0.y); w.y = pg8::cvt_pk_bf16(silu_f(g0.z) * u0.z, silu_f(g0.w) * u0.w);
                w.z = pg8::cvt_pk_bf16(silu_f(g1.x) * u1.x, silu_f(g1.y) * u1.y); w.w = pg8::cvt_pk_bf16(silu_f(g1.z) * u1.z, silu_f(g1.w) * u1.w);
                *(u32x4*)(hmid + (size_t)(row0 + ai * 128 + m * 16) * DEXP + col0) = w; }
    }
};
struct EpiMoe2 {
    static constexpr bool PERM = true;
    bf16_t* yexp;
    __device__ __forceinline__ void operator()(const f32x4 (&acc)[2][2][4][2], const pg8::Unit& u, int wr, int wc, int fr, int fq) const {
        const int row0 = u.pm * 256 + wr * 64 + fr, col0 = u.pn * 256 + wc * 32 + 8 * fq;
#pragma unroll
        for (int ai = 0; ai < 2; ++ai)
#pragma unroll
            for (int m = 0; m < 4; ++m)
#pragma unroll
                for (int bj = 0; bj < 2; ++bj) { const f32x4 v0 = acc[ai][bj][m][0], v1 = acc[ai][bj][m][1];
                    u32x4 w; w.x = pg8::cvt_pk_bf16(v0.x, v0.y); w.y = pg8::cvt_pk_bf16(v0.z, v0.w); w.z = pg8::cvt_pk_bf16(v1.x, v1.y); w.w = pg8::cvt_pk_bf16(v1.z, v1.w);
                    *(u32x4*)(yexp + (size_t)(row0 + ai * 128 + m * 16) * DM + col0 + bj * 128) = w; }
    }
};
__device__ __forceinline__ void st_moe1_fast(Ctx& c) {
    pg8::Gemm g{c_xs, c_wgu, DM, DM, DM};
    MoeSched S{c_tile_e, c.nblk, c.bid, 256 * DM * 2, 256 * DM * 2, 1024 * DM * 2};
    EpiMoe1 E{c_hmid};
    pg8::gemm_phase<EpiMoe1, MoeSched, true>(c.ldsp, g, S, E, c.tid);
}
__device__ __forceinline__ void st_moe2_fast(Ctx& c) {
    pg8::Gemm g{c_hmid, c_wd, DEXP, DEXP, DEXP};
    MoeSched S{c_tile_e, c.nblk, c.bid, 256 * DEXP * 2, 256 * DEXP * 2, 1024 * DEXP * 2};
    EpiMoe2 E{c_yexp};
    pg8::gemm_phase<EpiMoe2, MoeSched, true>(c.ldsp, g, S, E, c.tid);
}


typedef short bf16x8 __attribute__((ext_vector_type(8)));
typedef short s16x4 __attribute__((ext_vector_type(4)));
typedef float f32x16 __attribute__((ext_vector_type(16)));
#define MFMA32(a, b, c) __builtin_amdgcn_mfma_f32_32x32x16_bf16((a), (b), (c), 0, 0, 0)
#define SM_THR 8.0f
#define MASKV (-30000.0f)
__device__ __forceinline__ int crow(int r, int hi) { return (r & 3) + 8 * (r >> 2) + 4 * hi; }
__device__ __forceinline__ s16x4 vtr(const LAS char* p) { return __builtin_bit_cast(s16x4, __builtin_amdgcn_ds_read_tr16_b64_v4i16((LAS s16x4*)p)); }
__device__ __forceinline__ bf16x8 vfrag(const LAS char* p) { const s16x4 lo = vtr(p), hi = vtr(p + 512); return (bf16x8){lo[0], lo[1], lo[2], lo[3], hi[0], hi[1], hi[2], hi[3]}; }
__device__ __forceinline__ int vlane_off(int lane) { return (4 * (lane >> 5) + ((lane & 15) >> 2)) * 64 + (16 * ((lane >> 4) & 1) + 4 * (lane & 3)) * 2; }
__device__ __forceinline__ float max16(const f32x16& p) {
    float a = fmaxf(fmaxf(p[0], p[1]), fmaxf(p[2], p[3])), b = fmaxf(fmaxf(p[4], p[5]), fmaxf(p[6], p[7]));
    float cc = fmaxf(fmaxf(p[8], p[9]), fmaxf(p[10], p[11])), d = fmaxf(fmaxf(p[12], p[13]), fmaxf(p[14], p[15]));
    return fmaxf(fmaxf(a, b), fmaxf(cc, d));
}
__device__ __forceinline__ bf16x8 pack8(const f32x16& p, int s) {
    u32x4 w; w.x = pg8::cvt_pk_bf16(p[8 * s + 0], p[8 * s + 1]); w.y = pg8::cvt_pk_bf16(p[8 * s + 2], p[8 * s + 3]);
    w.z = pg8::cvt_pk_bf16(p[8 * s + 4], p[8 * s + 5]); w.w = pg8::cvt_pk_bf16(p[8 * s + 6], p[8 * s + 7]);
    return __builtin_bit_cast(bf16x8, w);
}
__device__ __forceinline__ float exp2_sum16(f32x16& p) {
    float s = 0.f;
#pragma unroll
    for (int r = 0; r < 16; ++r) { p[r] = __builtin_amdgcn_exp2f(p[r]); s += p[r]; }
    return s;
}
__device__ __forceinline__ void sm_update1(f32x16& p, float& mhat, float& lsum, f32x16& o0, f32x16& o1, bool first) {
    float rm = max16(p); rm = fmaxf(rm, __shfl_xor(rm, 32));
    const bool mv = first || __any(rm > SM_THR);
    if (mv) { const float dl = first ? fmaxf(rm, -64.f) : fmaxf(rm, 0.f); mhat += dl; const float f = __builtin_amdgcn_exp2f(-dl); lsum *= f;
#pragma unroll
        for (int r = 0; r < 16; ++r) { p[r] -= dl; o0[r] *= f; o1[r] *= f; } }
    lsum += exp2_sum16(p);
}
__device__ __forceinline__ void sm_update2(f32x16& pa, f32x16& pb, float& mhat, float& lsum, f32x16& o0, f32x16& o1, bool first) {
    float rm = fmaxf(max16(pa), max16(pb)); rm = fmaxf(rm, __shfl_xor(rm, 32));
    const bool mv = first || __any(rm > SM_THR);
    if (mv) { const float dl = first ? fmaxf(rm, -64.f) : fmaxf(rm, 0.f); mhat += dl; const float f = __builtin_amdgcn_exp2f(-dl); lsum *= f;
#pragma unroll
        for (int r = 0; r < 16; ++r) { pa[r] -= dl; pb[r] -= dl; o0[r] *= f; o1[r] *= f; } }
    lsum += exp2_sum16(pa) + exp2_sum16(pb);
}
__device__ __forceinline__ f32x16 splat16(float v) { f32x16 r;
#pragma unroll
    for (int i = 0; i < 16; ++i) r[i] = v;
    return r; }

__device__ __forceinline__ void diff_unit(Ctx& c, int unit, float lam, float lam_init, const float* sg) {
    const int tid = c.tid, lane = tid & 63, w = __builtin_amdgcn_readfirstlane(tid >> 6), q = lane & 31, hi = lane >> 5;
    const int b = unit >> 6, hh = (unit >> 4) & 3, qb = unit & 15;
    const bf16_t* zb = c_zmix + (size_t)b * SEQ * ZC;
    const size_t trow = (size_t)(qb * 256 + w * 32 + q);
    bf16x8 qf[4];
    { const bf16_t* qrow = zb + trow * ZC + C_DFQ + hh * 64;
#pragma unroll
      for (int d0 = 0; d0 < 4; ++d0) qf[d0] = *(const bf16x8*)(qrow + 16 * d0 + 8 * hi); }
    const bf16_t* ksrc = zb + C_DFK + hh * 64 + (size_t)lane * ZC + w * 8;
    const bf16_t* vsrc = zb + C_DFV + hh * 64 + (size_t)(16 * (w & 3) + (lane >> 2)) * ZC + (w >> 2) * 32 + (lane & 3) * 8;
    LAS char* L = (LAS char*)c.ldsp;
    const int sdst = w * 1024 + lane * 16;
    const LAS char* kbase = L + hi * 1024 + q * 16;
    const int vl = vlane_off(lane);
    float mh0 = 0.f, mh1 = 0.f, l0 = 0.f, l1 = 0.f;
    f32x16 o00 = splat16(0.f), o01 = splat16(0.f), o10 = splat16(0.f), o11 = splat16(0.f);
    __syncthreads();
    { const u32x4 kr = *(const u32x4*)ksrc, vr = *(const u32x4*)vsrc; *(LAS u32x4*)(L + sdst) = kr; *(LAS u32x4*)(L + 16384 + sdst) = vr; }
    __syncthreads();
    for (int t = 0; t < SEQ / 64; ++t) {
        const int cur = (t & 1) * 8192, nxt = 8192 - cur;
        u32x4 kr, vr;
        if (t + 1 < SEQ / 64) { kr = *(const u32x4*)(ksrc + (size_t)(t + 1) * 64 * ZC); vr = *(const u32x4*)(vsrc + (size_t)(t + 1) * 64 * ZC); }
        const LAS char* kb = kbase + cur;
        bf16x8 pf0[4], pf1[4];
        {
            f32x16 sa = splat16(-mh0), sb = sa;
            sa = MFMA32(*(const LAS bf16x8*)(kb + 0 * 2048), qf[0], sa); sb = MFMA32(*(const LAS bf16x8*)(kb + 0 * 2048 + 512), qf[0], sb);
            sa = MFMA32(*(const LAS bf16x8*)(kb + 1 * 2048), qf[1], sa); sb = MFMA32(*(const LAS bf16x8*)(kb + 1 * 2048 + 512), qf[1], sb);
            sm_update2(sa, sb, mh0, l0, o00, o01, t == 0);
            pf0[0] = pack8(sa, 0); pf0[1] = pack8(sa, 1); pf0[2] = pack8(sb, 0); pf0[3] = pack8(sb, 1);
        }
        {
            f32x16 sa = splat16(-mh1), sb = sa;
            sa = MFMA32(*(const LAS bf16x8*)(kb + 2 * 2048), qf[2], sa); sb = MFMA32(*(const LAS bf16x8*)(kb + 2 * 2048 + 512), qf[2], sb);
            sa = MFMA32(*(const LAS bf16x8*)(kb + 3 * 2048), qf[3], sa); sb = MFMA32(*(const LAS bf16x8*)(kb + 3 * 2048 + 512), qf[3], sb);
            sm_update2(sa, sb, mh1, l1, o10, o11, t == 0);
            pf1[0] = pack8(sa, 0); pf1[1] = pack8(sa, 1); pf1[2] = pack8(sb, 0); pf1[3] = pack8(sb, 1);
        }
        const LAS char* vb = L + 16384 + cur + vl;
#pragma unroll
        for (int kb16 = 0; kb16 < 4; ++kb16) {
            const bf16x8 v0 = vfrag(vb + kb16 * 1024), v1 = vfrag(vb + 4096 + kb16 * 1024);
            o00 = MFMA32(v0, pf0[kb16], o00); o01 = MFMA32(v1, pf0[kb16], o01);
            o10 = MFMA32(v0, pf1[kb16], o10); o11 = MFMA32(v1, pf1[kb16], o11);
        }
        if (t + 1 < SEQ / 64) { *(LAS u32x4*)(L + nxt + sdst) = kr; *(LAS u32x4*)(L + 16384 + nxt + sdst) = vr; }
        __syncthreads();
    }
    l0 += __shfl_xor(l0, 32); l1 += __shfl_xor(l1, 32);
    const float i0 = 1.f / l0, i1 = lam / l1;
    float ss = 0.f;
#pragma unroll
    for (int r = 0; r < 16; ++r) { o00[r] = o00[r] * i0 - o10[r] * i1; o01[r] = o01[r] * i0 - o11[r] * i1; ss += o00[r] * o00[r] + o01[r] * o01[r]; }
    ss += __shfl_xor(ss, 32);
    const float rr = (1.f - lam_init) / sqrtf(ss * (1.f / 64.f) + LN_EPS);
    bf16_t* yp = c_ys + ((size_t)b * SEQ + trow) * DM + 256 + hh * 64;
#pragma unroll
    for (int g = 0; g < 4; ++g) { const int d = 8 * g + 4 * hi;
        const f32x4 s0 = *(const f32x4*)(sg + d), s1 = *(const f32x4*)(sg + 32 + d);
        u32x2 wv; wv.x = pg8::cvt_pk_bf16(o00[4 * g] * rr * s0.x, o00[4 * g + 1] * rr * s0.y); wv.y = pg8::cvt_pk_bf16(o00[4 * g + 2] * rr * s0.z, o00[4 * g + 3] * rr * s0.w);
        *(u32x2*)(yp + d) = wv;
        wv.x = pg8::cvt_pk_bf16(o01[4 * g] * rr * s1.x, o01[4 * g + 1] * rr * s1.y); wv.y = pg8::cvt_pk_bf16(o01[4 * g + 2] * rr * s1.z, o01[4 * g + 3] * rr * s1.w);
        *(u32x2*)(yp + 32 + d) = wv; }
}
__device__ __forceinline__ void st_diff_fast(Ctx& c, int l) {
    const float* dl = c.a->in[6] + (size_t)l * 4 * 32;
    const float* sg = c.a->in[7] + (size_t)l * 64;
    const float lam_init = 0.8f - 0.6f * expf(-0.3f * (float)l);
    float s01 = 0.f, s23 = 0.f;
    for (int i = 0; i < 32; ++i) { s01 += dl[i] * dl[32 + i]; s23 += dl[64 + i] * dl[96 + i]; }
    const float lam = expf(s01) - expf(s23) + lam_init;
    for (int u = c.bid; u < 256; u += c.nblk) diff_unit(c, u, lam, lam_init, sg);
}

template <class RowF>
__device__ __forceinline__ void stage_v32(LAS char* img, int lane, RowF vrow) {
    u32x4 r[4];
#pragma unroll
    for (int i = 0; i < 4; ++i) { const int ci = i * 64 + lane, key = ci >> 3, ch = ci & 7; r[i] = *(const u32x4*)(vrow(key) + ch * 8); }
#pragma unroll
    for (int i = 0; i < 4; ++i) { const int ci = i * 64 + lane, key = ci >> 3, ch = ci & 7; *(LAS u32x4*)(img + (ch >> 2) * 2048 + key * 64 + (ch & 3) * 16) = r[i]; }
}
__device__ __forceinline__ void pv32(const LAS char* img, int vl, const f32x16& p, f32x16& o0, f32x16& o1) {
    const bf16x8 p0 = pack8(p, 0), p1 = pack8(p, 1);
    const bf16x8 v00 = vfrag(img + vl), v01 = vfrag(img + 2048 + vl), v10 = vfrag(img + 1024 + vl), v11 = vfrag(img + 2048 + 1024 + vl);
    o0 = MFMA32(v00, p0, o0); o1 = MFMA32(v01, p0, o1); o0 = MFMA32(v10, p1, o0); o1 = MFMA32(v11, p1, o1);
}
__device__ __forceinline__ void store_o64(bf16_t* yp, int hi, const f32x16& o0, const f32x16& o1, float inv) {
#pragma unroll
    for (int g = 0; g < 4; ++g) { const int d = 8 * g + 4 * hi; u32x2 wv;
        wv.x = pg8::cvt_pk_bf16(o0[4 * g] * inv, o0[4 * g + 1] * inv); wv.y = pg8::cvt_pk_bf16(o0[4 * g + 2] * inv, o0[4 * g + 3] * inv); *(u32x2*)(yp + d) = wv;
        wv.x = pg8::cvt_pk_bf16(o1[4 * g] * inv, o1[4 * g + 1] * inv); wv.y = pg8::cvt_pk_bf16(o1[4 * g + 2] * inv, o1[4 * g + 3] * inv); *(u32x2*)(yp + 32 + d) = wv; }
}
__device__ __forceinline__ void st_na_fast(Ctx& c, int l) {
    const int tid = c.tid, lane = tid & 63, w = __builtin_amdgcn_readfirstlane(tid >> 6), q = lane & 31, hi = lane >> 5;
    LAS char* img = (LAS char*)c.ldsp + w * 4096; const int vl = vlane_off(lane);
    const float* rp = c_rpbt + (size_t)l * 4 * 15 * 31;
    for (int task = c.bid * 8 + w; task < NB * 4 * 64 * 2; task += c.nblk * 8) {
        const int qh = task & 1, r = (task >> 1) & 63, hh = (task >> 7) & 3, b = task >> 9;
        const int cq = 32 * qh + q, rs = min(max(r - 4, 0), 56), cs = min(max(cq - 8, 0), 48);
        const bf16_t* zb = c_zmix + (size_t)b * SEQ * ZC;
        const size_t tq = (size_t)(r * 64 + cq);
        bf16x8 qf[4];
        { const bf16_t* qrow = zb + tq * ZC + C_NAQ + hh * 64;
#pragma unroll
          for (int d0 = 0; d0 < 4; ++d0) qf[d0] = *(const bf16x8*)(qrow + 16 * d0 + 8 * hi); }
        float mh = 0.f, ls = 0.f; f32x16 o0 = splat16(0.f), o1 = splat16(0.f);
        for (int it = 0; it < 16; ++it) {
            const int kk = it >> 1, ch = (it & 1) ^ qh, kr = rs + kk, dr = kr - r + 7;
            const bf16_t* kt = zb + (size_t)(kr * 64 + 32 * ch) * ZC + hh * 64;
            stage_v32(img, lane, [&](int key) { return kt + (size_t)key * ZC + C_NAV; });
            f32x16 p;
#pragma unroll
            for (int rg = 0; rg < 16; ++rg) { const int ck = 32 * ch + crow(rg, hi); const bool ok = (ck >= cs) && (ck < cs + 16);
                const int dc = min(max(ck - cq + 15, 0), 30);
                p[rg] = (ok ? rp[(hh * 15 + dr) * 31 + dc] : MASKV) - mh; }
            const bf16_t* krow = kt + (size_t)q * ZC + C_NAK + 8 * hi;
#pragma unroll
            for (int d0 = 0; d0 < 4; ++d0) p = MFMA32(*(const bf16x8*)(krow + 16 * d0), qf[d0], p);
            sm_update1(p, mh, ls, o0, o1, it == 0);
            pv32(img, vl, p, o0, o1);
        }
        ls += __shfl_xor(ls, 32);
        store_o64(c_ys + ((size_t)b * SEQ + tq) * DM + hh * 64, hi, o0, o1, 1.f / ls);
    }
}
__device__ __forceinline__ void st_dil_fast(Ctx& c) {
    const int tid = c.tid, lane = tid & 63, w = __builtin_amdgcn_readfirstlane(tid >> 6), q = lane & 31, hi = lane >> 5;
    LAS char* img = (LAS char*)c.ldsp + w * 4096; const int vl = vlane_off(lane);
    for (int task = c.bid * 8 + w; task < NB * 4 * 8 * 16; task += c.nblk * 8) {
        const int m16 = task & 15, blk = (task >> 4) & 7, hh = (task >> 7) & 3, b = task >> 9;
        const int s0 = blk * 512 + m16, sq = s0 + 16 * q;
        const bf16_t* zb = c_zmix + (size_t)b * SEQ * ZC;
        float mh = 0.f, ls = 0.f; f32x16 o0 = splat16(0.f), o1 = splat16(0.f);
        bool first = true;
        for (int p3 = 0; p3 < 3; ++p3) {
            const int sh = 2 * p3, rr = 1 << sh, Lp = SEQ >> sh, li0 = s0 >> sh, res = s0 & (rr - 1), st = 16 >> sh, li = li0 + q * st;
            const int ntile = (31 * st + 129 + 31) >> 5;
            const bf16_t* zp = zb + C_DL + p3 * 768 + hh * 64;
            bf16x8 qf[4];
            { const bf16_t* qrow = zp + (size_t)sq * ZC;
#pragma unroll
              for (int d0 = 0; d0 < 4; ++d0) qf[d0] = *(const bf16x8*)(qrow + 16 * d0 + 8 * hi); }
            for (int tt = 0; tt < ntile; ++tt) {
                const int lj0 = li0 - 64 + 32 * tt;
                auto keypos = [&](int key) { const int lj = min(max(lj0 + key, 0), Lp - 1); return (size_t)((lj << sh) + res); };
                stage_v32(img, lane, [&](int key) { return zp + keypos(key) * ZC + 512; });
                f32x16 p;
#pragma unroll
                for (int rg = 0; rg < 16; ++rg) { const int lj = lj0 + crow(rg, hi); const int df = lj - li; const bool ok = (lj >= 0) && (lj < Lp) && (df <= 64) && (df >= -64);
                    p[rg] = (ok ? 0.f : MASKV) - mh; }
                const bf16_t* krow = zp + keypos(q) * ZC + 256 + 8 * hi;
#pragma unroll
                for (int d0 = 0; d0 < 4; ++d0) p = MFMA32(*(const bf16x8*)(krow + 16 * d0), qf[d0], p);
                sm_update1(p, mh, ls, o0, o1, first); first = false;
                pv32(img, vl, p, o0, o1);
            }
        }
        ls += __shfl_xor(ls, 32);
        store_o64(c_ys + ((size_t)b * SEQ + sq) * DM + 768 + hh * 64, hi, o0, o1, 1.f / ls);
    }
}
__device__ __forceinline__ void st_pool_fast(Ctx& c, int l) {
    const int tid = c.tid, lane = tid & 63, w = __builtin_amdgcn_readfirstlane(tid >> 6), q = lane & 31, hi = lane >> 5;
    const bf16_t* pwt = c_pwt + (size_t)l * 4 * 64 * 64; const float* ps = c.a->in[9] + (size_t)l * 256;
    for (int task = c.bid * 8 + w; task < MT / 32; task += c.nblk * 8) {
        const int t = task * 32 + q, s = t & (SEQ - 1), b0 = t - s;
#pragma unroll
        for (int g = 0; g < 4; ++g) {
            const int wd = 2 << g, lo = max(s - wd / 2, 0), hi_ = min(s + wd - 1 - wd / 2, SEQ - 1);
            const float inv = 1.f / (float)(hi_ - lo + 1);
            bf16x8 df[4];
#pragma unroll
            for (int d0 = 0; d0 < 4; ++d0) {
                const bf16_t* up = c_zmix + C_PL + g * 64 + 16 * d0 + 8 * hi;
                float sum[8];
#pragma unroll
                for (int j = 0; j < 8; ++j) sum[j] = 0.f;
                for (int p = lo; p <= hi_; ++p) { const u32x4 v = *(const u32x4*)(up + (size_t)(b0 + p) * ZC);
                    sum[0] += lo16(v.x); sum[1] += hi16(v.x); sum[2] += lo16(v.y); sum[3] += hi16(v.y); sum[4] += lo16(v.z); sum[5] += hi16(v.z); sum[6] += lo16(v.w); sum[7] += hi16(v.w); }
                const u32x4 v = *(const u32x4*)(up + (size_t)t * ZC);
                u32x4 wv; wv.x = pg8::cvt_pk_bf16(sum[0] * inv - lo16(v.x), sum[1] * inv - hi16(v.x)); wv.y = pg8::cvt_pk_bf16(sum[2] * inv - lo16(v.y), sum[3] * inv - hi16(v.y));
                wv.z = pg8::cvt_pk_bf16(sum[4] * inv - lo16(v.z), sum[5] * inv - hi16(v.z)); wv.w = pg8::cvt_pk_bf16(sum[6] * inv - lo16(v.w), sum[7] * inv - hi16(v.w));
                df[d0] = __builtin_bit_cast(bf16x8, wv);
            }
#pragma unroll
            for (int eh = 0; eh < 2; ++eh) {
                f32x16 acc = splat16(0.f);
                const bf16_t* wp = pwt + ((size_t)g * 64 + 32 * eh + q) * 64 + 8 * hi;
#pragma unroll
                for (int d0 = 0; d0 < 4; ++d0) acc = MFMA32(*(const bf16x8*)(wp + 16 * d0), df[d0], acc);
                bf16_t* yp = c_ys + (size_t)t * DM + 512 + g * 64 + 32 * eh;
#pragma unroll
                for (int gg = 0; gg < 4; ++gg) { const int e = 8 * gg + 4 * hi; const f32x4 sc = *(const f32x4*)(ps + g * 64 + 32 * eh + e);
                    u32x2 wv; wv.x = pg8::cvt_pk_bf16(acc[4 * gg] * sc.x, acc[4 * gg + 1] * sc.y); wv.y = pg8::cvt_pk_bf16(acc[4 * gg + 2] * sc.z, acc[4 * gg + 3] * sc.w);
                    *(u32x2*)(yp + e) = wv; }
            }
        }
    }
}

__device__ __forceinline__ void st_rope(Ctx& c) {
    for (long i = c.gtid(); i < (long)MT * 256; i += c.ngt()) {
        const int t = (int)(i >> 8), j = (int)(i & 255), pos = t & (SEQ - 1);
        int col1, col2; float cs, sn;
        if (j < 64) { const int qk = j >> 5, hh = (j >> 3) & 3, m = (j >> 2) & 1, ii = j & 3;
            col1 = C_DFQ + qk * 256 + hh * 64 + m * 32 + ii; col2 = col1 + 4; cs = c_rc8[pos * 4 + ii]; sn = c_rs8[pos * 4 + ii]; }
        else { const int jj = j - 64, p = jj >> 6, r = jj & 63, qk = r >> 5, hh = (r >> 3) & 3, ii = r & 7;
            col1 = C_DL + p * 768 + qk * 256 + hh * 64 + ii; col2 = col1 + 8; cs = c_rc16[pos * 8 + ii]; sn = c_rs16[pos * 8 + ii]; }
        bf16_t* zr = c_zmix + (size_t)t * ZC;
        const float x1 = bf2f(zr[col1]), x2 = bf2f(zr[col2]);
        zr[col1] = (bf16_t)f2bf(x1 * cs - x2 * sn); zr[col2] = (bf16_t)f2bf(x1 * sn + x2 * cs);
    }
}

#define LOAD8(dst, p) const u32x4 dst = *(const u32x4*)(p)

__device__ __forceinline__ void st_na(Ctx& c, int l) {
    const float* rpb = c.a->in[5] + (size_t)l * 4 * 15 * 31;
    for (long i = c.gtid(); i < (long)MT * 4; i += c.ngt()) {
        const int s = (int)(i & (SEQ - 1)), hh = (int)((i >> 12) & 3), b = (int)(i >> 14);
        const int r = s >> 6, cq = s & 63;
        const int rs = min(max(r - 4, 0), 56), cs = min(max(cq - 8, 0), 48);
        const size_t t = (size_t)b * SEQ + s;
        float q[64], o[64];
        {
            const bf16_t* qp = c_zmix + t * ZC + C_NAQ + hh * 64;
#pragma unroll
            for (int d8 = 0; d8 < 8; ++d8) { LOAD8(w, qp + d8 * 8);
                q[d8 * 8 + 0] = lo16(w.x) * 0.125f; q[d8 * 8 + 1] = hi16(w.x) * 0.125f; q[d8 * 8 + 2] = lo16(w.y) * 0.125f; q[d8 * 8 + 3] = hi16(w.y) * 0.125f;
                q[d8 * 8 + 4] = lo16(w.z) * 0.125f; q[d8 * 8 + 5] = hi16(w.z) * 0.125f; q[d8 * 8 + 6] = lo16(w.w) * 0.125f; q[d8 * 8 + 7] = hi16(w.w) * 0.125f; }
        }
#pragma unroll
        for (int d = 0; d < 64; ++d) o[d] = 0.f;
        float mx = -INFINITY, ls = 0.f;
        for (int kk = 0; kk < 8; ++kk) {
            const int kr = rs + kk, dr = kr - r + 7;
            for (int cc = 0; cc < 16; ++cc) {
                const int ck = cs + cc, dc = ck - cq + 15;
                const size_t tk = (size_t)b * SEQ + kr * 64 + ck;
                const bf16_t* kp = c_zmix + tk * ZC + C_NAK + hh * 64;
                const bf16_t* vp = c_zmix + tk * ZC + C_NAV + hh * 64;
                float sc = rpb[(hh * 15 + dr) * 31 + dc];
#pragma unroll
                for (int d8 = 0; d8 < 8; ++d8) { LOAD8(w, kp + d8 * 8);
                    sc += q[d8 * 8 + 0] * lo16(w.x) + q[d8 * 8 + 1] * hi16(w.x) + q[d8 * 8 + 2] * lo16(w.y) + q[d8 * 8 + 3] * hi16(w.y)
                        + q[d8 * 8 + 4] * lo16(w.z) + q[d8 * 8 + 5] * hi16(w.z) + q[d8 * 8 + 6] * lo16(w.w) + q[d8 * 8 + 7] * hi16(w.w); }
                const float mn = fmaxf(mx, sc), al = __expf(mx - mn), p = __expf(sc - mn);
                ls = ls * al + p; mx = mn;
#pragma unroll
                for (int d8 = 0; d8 < 8; ++d8) { LOAD8(w, vp + d8 * 8);
                    o[d8 * 8 + 0] = o[d8 * 8 + 0] * al + p * lo16(w.x); o[d8 * 8 + 1] = o[d8 * 8 + 1] * al + p * hi16(w.x);
                    o[d8 * 8 + 2] = o[d8 * 8 + 2] * al + p * lo16(w.y); o[d8 * 8 + 3] = o[d8 * 8 + 3] * al + p * hi16(w.y);
                    o[d8 * 8 + 4] = o[d8 * 8 + 4] * al + p * lo16(w.z); o[d8 * 8 + 5] = o[d8 * 8 + 5] * al + p * hi16(w.z);
                    o[d8 * 8 + 6] = o[d8 * 8 + 6] * al + p * lo16(w.w); o[d8 * 8 + 7] = o[d8 * 8 + 7] * al + p * hi16(w.w); }
            }
        }
        const float inv = 1.f / ls;
        bf16_t* yp = c_ys + t * DM + 0 + hh * 64;
#pragma unroll
        for (int d8 = 0; d8 < 8; ++d8) { u32x4 w; w.x = pk2(o[d8 * 8 + 0] * inv, o[d8 * 8 + 1] * inv); w.y = pk2(o[d8 * 8 + 2] * inv, o[d8 * 8 + 3] * inv);
            w.z = pk2(o[d8 * 8 + 4] * inv, o[d8 * 8 + 5] * inv); w.w = pk2(o[d8 * 8 + 6] * inv, o[d8 * 8 + 7] * inv); *(u32x4*)(yp + d8 * 8) = w; }
    }
}

__device__ __forceinline__ void st_diff(Ctx& c, int l) {
    const float* dl = c.a->in[6] + (size_t)l * 4 * 32;
    const float* sg = c.a->in[7] + (size_t)l * 64;
    const float lam_init = 0.8f - 0.6f * expf(-0.3f * (float)l);
    float s01 = 0.f, s23 = 0.f;
    for (int i = 0; i < 32; ++i) { s01 += dl[i] * dl[32 + i]; s23 += dl[64 + i] * dl[96 + i]; }
    const float lam = expf(s01) - expf(s23) + lam_init;
    for (long i = c.gtid(); i < (long)MT * 8; i += c.ngt()) {
        const int m = (int)(i & 1), s = (int)((i >> 1) & (SEQ - 1)), hh = (int)((i >> 13) & 3), b = (int)(i >> 15);
        const size_t t = (size_t)b * SEQ + s;
        float q[32], o[64];
        { const bf16_t* qp = c_zmix + t * ZC + C_DFQ + hh * 64 + m * 32;
#pragma unroll
          for (int d8 = 0; d8 < 4; ++d8) { LOAD8(w, qp + d8 * 8); const float sc = 0.17677669529663687f;
              q[d8 * 8 + 0] = lo16(w.x) * sc; q[d8 * 8 + 1] = hi16(w.x) * sc; q[d8 * 8 + 2] = lo16(w.y) * sc; q[d8 * 8 + 3] = hi16(w.y) * sc;
              q[d8 * 8 + 4] = lo16(w.z) * sc; q[d8 * 8 + 5] = hi16(w.z) * sc; q[d8 * 8 + 6] = lo16(w.w) * sc; q[d8 * 8 + 7] = hi16(w.w) * sc; } }
#pragma unroll
        for (int d = 0; d < 64; ++d) o[d] = 0.f;
        float mx = -INFINITY, ls = 0.f;
        const bf16_t* kbase = c_zmix + (size_t)b * SEQ * ZC + C_DFK + hh * 64 + m * 32;
        const bf16_t* vbase = c_zmix + (size_t)b * SEQ * ZC + C_DFV + hh * 64;
        for (int j = 0; j < SEQ; ++j) {
            const bf16_t* kp = kbase + (size_t)j * ZC; const bf16_t* vp = vbase + (size_t)j * ZC;
            float sc = 0.f;
#pragma unroll
            for (int d8 = 0; d8 < 4; ++d8) { LOAD8(w, kp + d8 * 8);
                sc += q[d8 * 8 + 0] * lo16(w.x) + q[d8 * 8 + 1] * hi16(w.x) + q[d8 * 8 + 2] * lo16(w.y) + q[d8 * 8 + 3] * hi16(w.y)
                    + q[d8 * 8 + 4] * lo16(w.z) + q[d8 * 8 + 5] * hi16(w.z) + q[d8 * 8 + 6] * lo16(w.w) + q[d8 * 8 + 7] * hi16(w.w); }
            const float mn = fmaxf(mx, sc), al = __expf(mx - mn), p = __expf(sc - mn);
            ls = ls * al + p; mx = mn;
#pragma unroll
            for (int d8 = 0; d8 < 8; ++d8) { LOAD8(w, vp + d8 * 8);
                o[d8 * 8 + 0] = o[d8 * 8 + 0] * al + p * lo16(w.x); o[d8 * 8 + 1] = o[d8 * 8 + 1] * al + p * hi16(w.x);
                o[d8 * 8 + 2] = o[d8 * 8 + 2] * al + p * lo16(w.y); o[d8 * 8 + 3] = o[d8 * 8 + 3] * al + p * hi16(w.y);
                o[d8 * 8 + 4] = o[d8 * 8 + 4] * al + p * lo16(w.z); o[d8 * 8 + 5] = o[d8 * 8 + 5] * al + p * hi16(w.z);
                o[d8 * 8 + 6] = o[d8 * 8 + 6] * al + p * lo16(w.w); o[d8 * 8 + 7] = o[d8 * 8 + 7] * al + p * hi16(w.w); }
        }
        const float inv = 1.f / ls;
        float ss = 0.f;
#pragma unroll
        for (int d = 0; d < 64; ++d) { const float mine = o[d] * inv; const float oth = __shfl_xor(mine, 1); const float a = mine - lam * oth; o[d] = a; ss += a * a; }
        if (m == 0) {
            const float rr = 1.f / sqrtf(ss * (1.f / 64.f) + LN_EPS) * (1.f - lam_init);
            bf16_t* yp = c_ys + t * DM + 256 + hh * 64;
#pragma unroll
            for (int d8 = 0; d8 < 8; ++d8) { u32x4 w;
                w.x = pk2(o[d8 * 8 + 0] * rr * sg[d8 * 8 + 0], o[d8 * 8 + 1] * rr * sg[d8 * 8 + 1]); w.y = pk2(o[d8 * 8 + 2] * rr * sg[d8 * 8 + 2], o[d8 * 8 + 3] * rr * sg[d8 * 8 + 3]);
                w.z = pk2(o[d8 * 8 + 4] * rr * sg[d8 * 8 + 4], o[d8 * 8 + 5] * rr * sg[d8 * 8 + 5]); w.w = pk2(o[d8 * 8 + 6] * rr * sg[d8 * 8 + 6], o[d8 * 8 + 7] * rr * sg[d8 * 8 + 7]);
                *(u32x4*)(yp + d8 * 8) = w; }
        }
    }
}

__device__ __forceinline__ void st_pool(Ctx& c, int l) {
    const float* pw = c.a->in[8] + (size_t)l * 4 * 64 * 64;
    const float* ps = c.a->in[9] + (size_t)l * 256;
    for (long i = c.gtid(); i < (long)MT * 256; i += c.ngt()) {
        const int t = (int)(i >> 8), cc = (int)(i & 255), g = cc >> 6, e = cc & 63, w = 2 << g;
        const int s = t & (SEQ - 1), b0 = t - s;
        const int lo = max(s - w / 2, 0), hi = min(s + w - 1 - w / 2, SEQ - 1);
        const float inv = 1.f / (float)(hi - lo + 1);
        float acc = 0.f;
        for (int k = 0; k < 64; ++k) {
            float sum = 0.f;
            for (int p = lo; p <= hi; ++p) sum += bf2f(c_zmix[(size_t)(b0 + p) * ZC + C_PL + g * 64 + k]);
            const float dlt = sum * inv - bf2f(c_zmix[(size_t)t * ZC + C_PL + g * 64 + k]);
            acc += dlt * pw[(g * 64 + k) * 64 + e];
        }
        c_ys[(size_t)t * DM + 512 + cc] = (bf16_t)f2bf(acc * ps[cc]);
    }
}

__device__ __forceinline__ void st_dil(Ctx& c) {
    for (long i = c.gtid(); i < (long)MT * 4; i += c.ngt()) {
        const int s = (int)(i & (SEQ - 1)), hh = (int)((i >> 12) & 3), b = (int)(i >> 14);
        const size_t t = (size_t)b * SEQ + s;
        float q[64], o[64];
#pragma unroll
        for (int d = 0; d < 64; ++d) o[d] = 0.f;
        float mx = -INFINITY, ls = 0.f;
        for (int p = 0; p < 3; ++p) {
            const int sh = 2 * p, r = 1 << sh, L = SEQ >> sh, li = s >> sh, res = s & (r - 1);
            { const bf16_t* qp = c_zmix + t * ZC + C_DL + p * 768 + hh * 64;
#pragma unroll
              for (int d8 = 0; d8 < 8; ++d8) { LOAD8(w, qp + d8 * 8);
                  q[d8 * 8 + 0] = lo16(w.x) * 0.125f; q[d8 * 8 + 1] = hi16(w.x) * 0.125f; q[d8 * 8 + 2] = lo16(w.y) * 0.125f; q[d8 * 8 + 3] = hi16(w.y) * 0.125f;
                  q[d8 * 8 + 4] = lo16(w.z) * 0.125f; q[d8 * 8 + 5] = hi16(w.z) * 0.125f; q[d8 * 8 + 6] = lo16(w.w) * 0.125f; q[d8 * 8 + 7] = hi16(w.w) * 0.125f; } }
            for (int j = -64; j <= 64; ++j) {
                const int lj = li + j;
                if (lj < 0 || lj >= L) continue;
                const size_t tk = (size_t)b * SEQ + ((size_t)lj << sh) + res;
                const bf16_t* kp = c_zmix + tk * ZC + C_DL + p * 768 + 256 + hh * 64;
                const bf16_t* vp = c_zmix + tk * ZC + C_DL + p * 768 + 512 + hh * 64;
                float sc = 0.f;
#pragma unroll
                for (int d8 = 0; d8 < 8; ++d8) { LOAD8(w, kp + d8 * 8);
                    sc += q[d8 * 8 + 0] * lo16(w.x) + q[d8 * 8 + 1] * hi16(w.x) + q[d8 * 8 + 2] * lo16(w.y) + q[d8 * 8 + 3] * hi16(w.y)
                        + q[d8 * 8 + 4] * lo16(w.z) + q[d8 * 8 + 5] * hi16(w.z) + q[d8 * 8 + 6] * lo16(w.w) + q[d8 * 8 + 7] * hi16(w.w); }
                const float mn = fmaxf(mx, sc), al = __expf(mx - mn), pp = __expf(sc - mn);
                ls = ls * al + pp; mx = mn;
#pragma unroll
                for (int d8 = 0; d8 < 8; ++d8) { LOAD8(w, vp + d8 * 8);
                    o[d8 * 8 + 0] = o[d8 * 8 + 0] * al + pp * lo16(w.x); o[d8 * 8 + 1] = o[d8 * 8 + 1] * al + pp * hi16(w.x);
                    o[d8 * 8 + 2] = o[d8 * 8 + 2] * al + pp * lo16(w.y); o[d8 * 8 + 3] = o[d8 * 8 + 3] * al + pp * hi16(w.y);
                    o[d8 * 8 + 4] = o[d8 * 8 + 4] * al + pp * lo16(w.z); o[d8 * 8 + 5] = o[d8 * 8 + 5] * al + pp * hi16(w.z);
                    o[d8 * 8 + 6] = o[d8 * 8 + 6] * al + pp * lo16(w.w); o[d8 * 8 + 7] = o[d8 * 8 + 7] * al + pp * hi16(w.w); }
            }
        }
        const float inv = 1.f / ls;
        bf16_t* yp = c_ys + t * DM + 768 + hh * 64;
#pragma unroll
        for (int d8 = 0; d8 < 8; ++d8) { u32x4 w; w.x = pk2(o[d8 * 8 + 0] * inv, o[d8 * 8 + 1] * inv); w.y = pk2(o[d8 * 8 + 2] * inv, o[d8 * 8 + 3] * inv);
            w.z = pk2(o[d8 * 8 + 4] * inv, o[d8 * 8 + 5] * inv); w.w = pk2(o[d8 * 8 + 6] * inv, o[d8 * 8 + 7] * inv); *(u32x4*)(yp + d8 * 8) = w; }
    }
}

__device__ __forceinline__ void st_merge(Ctx& c, int l) {
    const float* wb = c.a->in[10] + (size_t)l * 4 * 256 * DM;
    for (long i = c.gtid(); i < (long)MT * DM; i += c.ngt()) {
        const int t = (int)(i >> 10), d = (int)(i & 1023);
        float tot = 0.f;
        for (int n = 0; n < 4; ++n) {
            const bf16_t* yp = c_ys + (size_t)t * DM + n * 256;
            const float* wp = wb + (size_t)n * 256 * DM + d;
            float a = 0.f;
            for (int c8 = 0; c8 < 32; ++c8) { LOAD8(w, yp + c8 * 8); const float* w8 = wp + (size_t)c8 * 8 * DM;
                a += lo16(w.x) * w8[0] + hi16(w.x) * w8[DM] + lo16(w.y) * w8[2 * DM] + hi16(w.y) * w8[3 * DM]
                   + lo16(w.z) * w8[4 * DM] + hi16(w.z) * w8[5 * DM] + lo16(w.w) * w8[6 * DM] + hi16(w.w) * w8[7 * DM]; }
            tot += bf2f(c_gates[(size_t)t * GC + n * DM + d]) * a;
        }
        c_merged[(size_t)t * DM + d] = (bf16_t)f2bf(tot);
    }
}

__device__ __forceinline__ void st_outgemm(Ctx& c, int l) {
    const float* W = c.a->in[11] + (size_t)l * DM * DM;
    for (long i = c.gtid(); i < CAP; i += c.ngt()) c_tok[i] = -1;
    for (int t = c.bid; t < (MT / 64) * (DM / 128); t += c.nblk) {
        const int tn = t % (DM / 128), tm = t / (DM / 128), m0 = tm * 64, n0 = tn * 128;
        const bf16_t* mg = c_merged; const float* h = c.h; float* ypre = c_ypre;
        ngemm_tile(c.sm(), c.tid, DM,
            [&](int r, int k) { return bf2f(mg[(size_t)(m0 + r) * DM + k]); },
            [&](int k, int c4) { return *(const f32x4*)(W + (size_t)k * DM + n0 + c4); },
            [&](int r, int c4, f32x4 v) { const size_t off = (size_t)(m0 + r) * DM + n0 + c4;
                const f32x4 hv = *(const f32x4*)(h + off); *(f32x4*)(ypre + off) = ALPHA * hv + v; });
    }
}

__device__ __forceinline__ void st_ln1_router(Ctx& c, int l) {
    const float* g1 = c.a->in[12] + (size_t)l * DM; const float* b1 = c.a->in[13] + (size_t)l * DM;
    const float* rgw = c.a->in[14] + (size_t)l * DM * 4; const float* rgb = c.a->in[15] + (size_t)l * 4;
    const float* rew = c.a->in[16] + (size_t)l * DM * 32; const float* reb = c.a->in[17] + (size_t)l * 32;
    unsigned* cnt = c_ctl + CW_CNT + l * 32;
    for (int m = c.gw(); m < MT; m += c.ngw()) {
        f32x4 v[4];
#pragma unroll
        for (int j = 0; j < 4; ++j) v[j] = *(const f32x4*)(c_ypre + (size_t)m * DM + 4 * c.lane() + 256 * j);
        wave_ln_store(v, g1, b1, c.h + (size_t)m * DM, c_hb + (size_t)m * DM, c.lane());
        float gl[4] = {0.f, 0.f, 0.f, 0.f};
#pragma unroll
        for (int j = 0; j < 4; ++j) {
            const int k0 = 4 * c.lane() + 256 * j;
#pragma unroll
            for (int e = 0; e < 4; ++e) { const float hv = v[j][e]; const f32x4 w = *(const f32x4*)(rgw + (size_t)(k0 + e) * 4);
                gl[0] += hv * w.x; gl[1] += hv * w.y; gl[2] += hv * w.z; gl[3] += hv * w.w; }
        }
#pragma unroll
        for (int q = 0; q < 4; ++q) gl[q] = wave_sum(gl[q]) + rgb[q];
        int gs = 0; float gm = gl[0];
#pragma unroll
        for (int q = 1; q < 4; ++q) if (gl[q] > gm) { gm = gl[q]; gs = q; }
        float den = 0.f;
#pragma unroll
        for (int q = 0; q < 4; ++q) den += expf(gl[q] - gm);
        const float pg = 1.f / den;
        float el[8];
#pragma unroll
        for (int q = 0; q < 8; ++q) el[q] = 0.f;
#pragma unroll
        for (int j = 0; j < 4; ++j) {
            const int k0 = 4 * c.lane() + 256 * j;
#pragma unroll
            for (int e = 0; e < 4; ++e) { const float hv = v[j][e]; const float* wp = rew + (size_t)(k0 + e) * 32 + gs * 8;
                const f32x4 w0 = *(const f32x4*)wp, w1 = *(const f32x4*)(wp + 4);
                el[0] += hv * w0.x; el[1] += hv * w0.y; el[2] += hv * w0.z; el[3] += hv * w0.w;
                el[4] += hv * w1.x; el[5] += hv * w1.y; el[6] += hv * w1.z; el[7] += hv * w1.w; }
        }
#pragma unroll
        for (int q = 0; q < 8; ++q) el[q] = wave_sum(el[q]) + reb[gs * 8 + q];
        int i1 = 0; float v1 = el[0];
#pragma unroll
        for (int q = 1; q < 8; ++q) if (el[q] > v1) { v1 = el[q]; i1 = q; }
        int i2 = -1; float v2 = -INFINITY;
#pragma unroll
        for (int q = 0; q < 8; ++q) if (q != i1 && el[q] > v2) { v2 = el[q]; i2 = q; }
        const float e2 = expf(v2 - v1), g1w = pg / (1.f + e2), g2w = pg * e2 / (1.f + e2);
        if (c.lane() == 0) {
            const int ea = gs * 8 + i1, eb = gs * 8 + i2;
            c_eid[m * 2] = ea; c_eid[m * 2 + 1] = eb; c_gwt[m * 2] = g1w; c_gwt[m * 2 + 1] = g2w;
            atomicAdd(cnt + ea, 1u); atomicAdd(cnt + eb, 1u);
        }
    }
}

__device__ __forceinline__ void st_pack(Ctx& c, int l) {
    unsigned* cnt = c_ctl + CW_CNT + l * 32; unsigned* cur = c_ctl + CW_CUR + l * 32;
    int* offs = (int*)c.sm();
    if (c.tid == 0) { int o = 0; for (int e = 0; e < NEXP; ++e) { offs[e] = o; const int n = (int)__hip_atomic_load(cnt + e, __ATOMIC_RELAXED, __HIP_MEMORY_SCOPE_AGENT); o += (n + 255) / 256 * 256; } offs[32] = o; }
    __syncthreads();
    if (c.bid == 0) {
        for (int i = c.tid; i < NTILE; i += NTHR) { const int row = i * 256; int e = -1;
            if (row < offs[32]) { e = 0; for (int q = 1; q < NEXP; ++q) if (row >= offs[q]) e = q; }
            c_tile_e[i] = e; }
    }
    for (long i = c.gtid(); i < (long)MT * 2; i += c.ngt()) {
        const int e = c_eid[i];
        const int pos = offs[e] + (int)atomicAdd(cur + e, 1u);
        c_slot[i] = pos; c_tok[pos] = (int)(i >> 1);
    }
    __syncthreads();
}

__device__ __forceinline__ float silu(float x) { return x / (1.f + __expf(-x)); }

__device__ __forceinline__ void st_moe1(Ctx& c, int l) {
    const float* WG = c.a->in[18] + (size_t)l * NEXP * DM * DEXP;
    const float* WU = c.a->in[19] + (size_t)l * NEXP * DM * DEXP;
    for (int t = c.bid; t < (CAP / 64) * (DEXP / 64); t += c.nblk) {
        const int tn = t % (DEXP / 64), tm = t / (DEXP / 64), m0 = tm * 64, j0 = tn * 64;
        const int e = c_tile_e[m0 >> 8];
        if (e < 0) continue;
        const float* wg = WG + (size_t)e * DM * DEXP; const float* wu = WU + (size_t)e * DM * DEXP;
        const bf16_t* hb = c_hb; const int* tok = c_tok; bf16_t* hmid = c_hmid;
        ngemm_tile(c.sm(), c.tid, DM,
            [&](int r, int k) { const int tk = tok[m0 + r]; return tk < 0 ? 0.f : bf2f(hb[(size_t)tk * DM + k]); },
            [&](int k, int c4) { return c4 < 64 ? *(const f32x4*)(wg + (size_t)k * DEXP + j0 + c4) : *(const f32x4*)(wu + (size_t)k * DEXP + j0 + c4 - 64); },
            [&](int r, int c4, f32x4 v) {
                f32x4 o; o.x = __shfl_xor(v.x, 16); o.y = __shfl_xor(v.y, 16); o.z = __shfl_xor(v.z, 16); o.w = __shfl_xor(v.w, 16);
                if (c4 < 64) { u32x2 w; w.x = pk2(silu(v.x) * o.x, silu(v.y) * o.y); w.y = pk2(silu(v.z) * o.z, silu(v.w) * o.w);
                    *(u32x2*)(hmid + (size_t)(m0 + r) * DEXP + j0 + c4) = w; }
            });
    }
}

__device__ __forceinline__ void st_moe2(Ctx& c, int l) {
    const float* WD = c.a->in[20] + (size_t)l * NEXP * DEXP * DM;
    for (int t = c.bid; t < (CAP / 64) * (DM / 128); t += c.nblk) {
        const int tn = t % (DM / 128), tm = t / (DM / 128), m0 = tm * 64, n0 = tn * 128;
        const int e = c_tile_e[m0 >> 8];
        if (e < 0) continue;
        const float* wd = WD + (size_t)e * DEXP * DM;
        const bf16_t* hmid = c_hmid; bf16_t* yexp = c_yexp;
        ngemm_tile(c.sm(), c.tid, DEXP,
            [&](int r, int k) { return bf2f(hmid[(size_t)(m0 + r) * DEXP + k]); },
            [&](int k, int c4) { return *(const f32x4*)(wd + (size_t)k * DM + n0 + c4); },
            [&](int r, int c4, f32x4 v) { u32x2 w; w.x = pk2(v.x, v.y); w.y = pk2(v.z, v.w); *(u32x2*)(yexp + (size_t)(m0 + r) * DM + n0 + c4) = w; });
    }
}

__device__ __forceinline__ void st_combine(Ctx& c, int l) {
    const float* g2 = c.a->in[21] + (size_t)l * DM; const float* b2 = c.a->in[22] + (size_t)l * DM;
    for (int m = c.gw(); m < MT; m += c.ngw()) {
        const int s0 = c_slot[m * 2], s1 = c_slot[m * 2 + 1]; const float w0 = c_gwt[m * 2], w1 = c_gwt[m * 2 + 1];
        f32x4 v[4];
#pragma unroll
        for (int j = 0; j < 4; ++j) {
            const int col = 4 * c.lane() + 256 * j;
            const f32x4 hv = *(const f32x4*)(c.h + (size_t)m * DM + col);
            const u32x2 a = *(const u32x2*)(c_yexp + (size_t)s0 * DM + col), b = *(const u32x2*)(c_yexp + (size_t)s1 * DM + col);
            f32x4 r;
            r.x = ALPHA * hv.x + w0 * lo16(a.x) + w1 * lo16(b.x); r.y = ALPHA * hv.y + w0 * hi16(a.x) + w1 * hi16(b.x);
            r.z = ALPHA * hv.z + w0 * lo16(a.y) + w1 * lo16(b.y); r.w = ALPHA * hv.w + w0 * hi16(a.y) + w1 * hi16(b.y);
            v[j] = r;
        }
        wave_ln_store(v, g2, b2, c.h + (size_t)m * DM, c_hb + (size_t)m * DM, c.lane());
    }
}


#define XB_TMO      128
#define XB_XCNT(j)  (256  + 64 * (j))
#define XB_XSUB(j)  (1280 + 64 * (j))
#define XB_XGEN(j)  (2304 + 64 * (j))
#define XB_TOP      3328
#define XB_TOPGEN   3392
#define XCD_BAR_WORDS 3456
#define XB_SPIN_CAP (1u << 22)
constexpr int CW_BAR = 4096;
__device__ __forceinline__ unsigned xb_ld(unsigned* p)              { return __hip_atomic_load(p, __ATOMIC_RELAXED, __HIP_MEMORY_SCOPE_AGENT); }
__device__ __forceinline__ unsigned xb_add(unsigned* p, unsigned v) { return __hip_atomic_fetch_add(p, v, __ATOMIC_RELAXED, __HIP_MEMORY_SCOPE_AGENT); }
__device__ __forceinline__ unsigned xb_xcc_id() { return (unsigned)__builtin_amdgcn_s_getreg((3 << 11) | 20) & 0xFu; }
#define XB_SPIN(cond, bar) do { unsigned _sp = 0; while (cond) { __builtin_amdgcn_s_sleep(1); \
    if ((++_sp & 255u) == 0u) { if (xb_ld(&(bar)[XB_TMO])) break; if (_sp > XB_SPIN_CAP) { atomicAdd(&(bar)[XB_TMO], 1u); break; } } } } while (0)
struct XcdBarrier { unsigned* bar; unsigned x; volatile LAS unsigned* st; };
__device__ __forceinline__ XcdBarrier xcd_barrier_post(unsigned* bar, volatile LAS unsigned* st) {
    XcdBarrier b; b.bar = bar; b.x = xb_xcc_id(); b.st = st;
    if (threadIdx.x == 0) (void)xb_add(&bar[XB_XCNT(b.x)], 1u);
    return b;
}
__device__ __forceinline__ void xcd_barrier_complete(unsigned* bar, unsigned x, unsigned& nloc, unsigned& nx) {
    const unsigned G = gridDim.x * gridDim.y * gridDim.z;
    unsigned sum, cnt, mine, sp = 0u;
    for (;;) {
        sum = 0u; cnt = 0u; mine = 0u;
#pragma unroll
        for (unsigned j = 0; j < 16; ++j) { const unsigned cc = xb_ld(&bar[XB_XCNT(j)]); sum += cc; cnt += (cc > 0u) ? 1u : 0u; mine = (j == x) ? cc : mine; }
        if (sum == G) break;
        __builtin_amdgcn_s_sleep(1);
        if ((++sp & 255u) == 0u) { if (xb_ld(&bar[XB_TMO])) break; if (sp > XB_SPIN_CAP) { atomicAdd(&bar[XB_TMO], 1u); break; } }
    }
    nloc = mine > 0u ? mine : 1u; nx = cnt > 0u ? cnt : 1u;
}
__device__ __forceinline__ void xcd_barrier(const XcdBarrier& b) {
    asm volatile("s_waitcnt vmcnt(0)" ::: "memory");
    __syncthreads();
    if (threadIdx.x == 0) {
        unsigned* bar = b.bar;
        __builtin_amdgcn_s_waitcnt(0);
        unsigned nloc = b.st[0], nx = b.st[1];
        if (nloc == 0u) { xcd_barrier_complete(bar, b.x, nloc, nx); b.st[0] = nloc; b.st[1] = nx; }
        const unsigned old = xb_add(&bar[XB_XSUB(b.x)], 1u);
        const unsigned gen = old / nloc;
        if (old + 1u == (gen + 1u) * nloc) {
            __builtin_amdgcn_fence(__ATOMIC_RELEASE, "agent");
            asm volatile("s_waitcnt vmcnt(0)" ::: "memory");
            const unsigned og = xb_add(&bar[XB_TOP], 1u);
            const unsigned tg = og / nx;
            if (og + 1u == (tg + 1u) * nx) xb_add(&bar[XB_TOPGEN], 1u);
            else XB_SPIN(xb_ld(&bar[XB_TOPGEN]) == tg, bar);
            __builtin_amdgcn_fence(__ATOMIC_ACQUIRE, "agent");
            xb_add(&bar[XB_XGEN(b.x)], 1u);
            asm volatile("s_waitcnt vmcnt(0)" ::: "memory");
        } else {
            XB_SPIN(xb_ld(&bar[XB_XGEN(b.x)]) == gen, bar);
            __builtin_amdgcn_fence(__ATOMIC_ACQUIRE, "agent");
            asm volatile("s_waitcnt vmcnt(0)" ::: "memory");
        }
    }
    __syncthreads();
}

constexpr int PH_PER_LAYER = 10, N_PHASES = 1 + NLAYER * PH_PER_LAYER;

__global__ void __launch_bounds__(NTHR, 2) fwd(Args args) {
    extern __shared__ __attribute__((aligned(16))) unsigned char lds[];
    volatile LAS unsigned* bst = (volatile LAS unsigned*)((LAS unsigned char*)lds + 131072 + 512);
    if (threadIdx.x == 0) { bst[0] = 0u; bst[1] = 0u; }
    __syncthreads();
    const XcdBarrier gbar = xcd_barrier_post((unsigned*)(args.ws + WS_CTL) + CW_BAR, bst);
    for (int ph = args.ph_lo; ph < args.ph_hi; ++ph) {
        Ctx c;
        int tid_ = threadIdx.x, bid_ = blockIdx.x, nblk_ = gridDim.x;
        unsigned char* ws_ = args.ws; float* out_ = args.out;
        asm volatile("" : "+v"(tid_), "+s"(bid_), "+s"(nblk_), "+s"(ws_), "+s"(out_));
        c.a = &args; c.tid = tid_; c.bid = bid_; c.nblk = nblk_; c.ws = ws_; c.h = out_; c.ldsp = (LAS unsigned char*)lds;
        if (ph == 0) { st_prologue(c); st_convert_common(c); st_convert_experts(c, 0); }
        else {
            const int l = (ph - 1) / PH_PER_LAYER, j = (ph - 1) % PH_PER_LAYER;
            switch (j) {
                case 0: st_zgemm_fast(c, l); break;
                case 1: st_diff_fast(c, l); st_na_fast(c, l); st_dil_fast(c); st_pool_fast(c, l); break;
                case 2: st_branch_fast(c, l); break;
                case 3: st_sum4(c); break;
                case 4: st_outgemm_fast(c, l); break;
                case 5: st_ln1_router(c, l); break;
                case 6: st_pack_fast(c, l); break;
                case 7: st_moe1_fast(c); break;
                case 8: st_moe2_fast(c); break;
                default: st_combine(c, l); if (l + 1 < NLAYER) st_convert_experts(c, l + 1); break;
            }
        }
        if (ph + 1 < args.ph_hi) xcd_barrier(gbar);
    }
}

extern "C" void kernel_launch(void* const* d_in, const int* in_sizes, int n_in, void* d_out, int out_size, void* d_ws, size_t ws_size, hipStream_t stream) {
    static int grid_blocks = 0;
    if (grid_blocks == 0) {
        if (n_in != 23 || out_size != MT * DM || ws_size < WS_END) { fprintf(stderr, "kernel_launch: unexpected shapes n_in %d out %d ws %zu\n", n_in, out_size, ws_size); grid_blocks = -1; return; }
        int dev = 0, cus = 0, per_cu = 0;
        hipGetDevice(&dev);
        hipDeviceGetAttribute(&cus, hipDeviceAttributeMultiprocessorCount, dev);
        hipFuncSetAttribute((const void*)fwd, hipFuncAttributeMaxDynamicSharedMemorySize, LDS_BYTES);
        hipOccupancyMaxActiveBlocksPerMultiprocessor(&per_cu, (const void*)fwd, NTHR, LDS_BYTES);
        if (per_cu < 1) { fprintf(stderr, "kernel_launch: occupancy query says %d blocks per CU\n", per_cu); per_cu = 1; }
        (void)hipGetLastError();
        grid_blocks = cus * per_cu;
    }
    if (grid_blocks < 0) return;
    hipMemsetAsync((char*)d_ws + WS_CTL, 0, CTL_BYTES, stream);
    Args a{};
    for (int i = 0; i < 23; ++i) a.in[i] = (const float*)d_in[i];
    a.out = (float*)d_out; a.ws = (unsigned char*)d_ws;
    for (int i = 0; i < 4; ++i) a.invf8[i] = exp((double)i * (-2.0 * log(500000.0) / 8.0));
    for (int i = 0; i < 8; ++i) a.invf16[i] = exp((double)i * (-2.0 * log(500000.0) / 16.0));
    a.ph_lo = 0; a.ph_hi = N_PHASES;
    void* kargs[] = {&a};
    hipError_t e = hipLaunchCooperativeKernel((const void*)fwd, dim3(grid_blocks), dim3(NTHR), kargs, LDS_BYTES, stream);
    if (e != hipSuccess) fprintf(stderr, "cooperative launch failed: %s (grid %d)\n", hipGetErrorString(e), grid_blocks);
}
```
